# Optimizing an MI355X kernel written in HIP

```python
import math
import jax, jax.numpy as jnp
from jax import lax
import numpy as np

D_MODEL = 1024
BATCH = 8
SEQ = 2048
DEPTH = 1
DEC_BATCH = 128
DEC_SEQ = 8
PAST_LEN = 8192
PAGE_SIZE = 128

WINDOW = 128
A_HEADS = 8
A_KV_HEADS = 2
A_HEAD_DIM = 64
A_GROUP = A_HEADS // A_KV_HEADS
B_HEADS = 4
B_KEY_DIM = 128
B_VAL_DIM = 128
CONV_W = 4
DN_CHUNK = 64
CONV_DIM = B_HEADS * (2 * B_KEY_DIM + B_VAL_DIM)
D_FF = 2816
EPS = 1e-6
IN_SIZES = (A_HEADS * A_HEAD_DIM, A_KV_HEADS * A_HEAD_DIM, A_KV_HEADS * A_HEAD_DIM,
            CONV_DIM, B_HEADS * B_VAL_DIM, B_HEADS, B_HEADS, D_MODEL, D_MODEL)
IN_DIM = sum(IN_SIZES)

kernel_name = 'hybrid_swa_sink_gated_deltanet_macaron_step'


def rms_norm(x, w):
    xf = x.astype(jnp.float32)
    y = xf * lax.rsqrt(jnp.mean(xf * xf, axis=-1, keepdims=True) + EPS)
    return (y * w.astype(jnp.float32)).astype(x.dtype)


def l2_normalize(x):
    return x * lax.rsqrt(jnp.sum(x * x, axis=-1, keepdims=True) + EPS)


def swiglu_ffn(x, w_up, w_down):
    gate, up = jnp.split(x @ w_up, 2, axis=-1)
    return (jax.nn.silu(gate) * up) @ w_down


def split_columns(z):
    offsets = [int(o) for o in np.cumsum(IN_SIZES)[:-1]]
    return jnp.split(z, offsets, axis=-1)


def sink_attend(q, k, v, mask, sinks):
    s = jnp.einsum('...qkgd,...skd->...kgqs', q, k, preferred_element_type=jnp.float32) * (A_HEAD_DIM ** -0.5)
    s = jnp.where(mask, s, -jnp.inf)
    sink = sinks.astype(jnp.float32).reshape(A_KV_HEADS, A_GROUP, 1, 1)
    m = jnp.maximum(jnp.max(s, axis=-1, keepdims=True), sink)
    e = jnp.exp(s - m)
    p = e / (jnp.sum(e, axis=-1, keepdims=True) + jnp.exp(sink - m))
    return jnp.einsum('...kgqs,...skd->...qkgd', p.astype(v.dtype), v)


def swa_prompt(q, k, v, sinks):
    bsz, seq, _ = q.shape
    nb = seq // WINDOW
    q = q.reshape(bsz, nb, WINDOW, A_KV_HEADS, A_GROUP, A_HEAD_DIM)
    pad = jnp.zeros((bsz, WINDOW, A_KV_HEADS, A_HEAD_DIM), k.dtype)
    kp = jnp.concatenate([pad, k], axis=1).reshape(bsz, nb + 1, WINDOW, A_KV_HEADS, A_HEAD_DIM)
    vp = jnp.concatenate([pad, v], axis=1).reshape(bsz, nb + 1, WINDOW, A_KV_HEADS, A_HEAD_DIM)
    kband = jnp.concatenate([kp[:, :-1], kp[:, 1:]], axis=2)
    vband = jnp.concatenate([vp[:, :-1], vp[:, 1:]], axis=2)
    n = jnp.arange(nb)[:, None, None]
    i = jnp.arange(WINDOW)[None, :, None]
    j = jnp.arange(2 * WINDOW)[None, None, :]
    diff = WINDOW + i - j
    mask = (diff >= 0) & (diff < WINDOW) & (n * WINDOW - WINDOW + j >= 0)
    o = sink_attend(q, kband, vband, mask[:, None, None], sinks)
    return o.reshape(bsz, seq, A_HEADS * A_HEAD_DIM), k[:, -WINDOW:], v[:, -WINDOW:]


def swa_sample(q, k, v, buf_k, buf_v, sinks):
    bsz, t, _ = q.shape
    wb = buf_k.shape[1]
    q = q.reshape(bsz, t, A_KV_HEADS, A_GROUP, A_HEAD_DIM)
    kc = jnp.concatenate([buf_k, k], axis=1)
    vc = jnp.concatenate([buf_v, v], axis=1)
    diff = (wb + jnp.arange(t))[:, None] - jnp.arange(wb + t)[None, :]
    mask = (diff >= 0) & (diff < WINDOW)
    o = sink_attend(q, kc, vc, mask, sinks)
    return o.reshape(bsz, t, A_HEADS * A_HEAD_DIM), kc[:, -wb:], vc[:, -wb:]


def causal_short_conv(x, buf, w):
    t = x.shape[1]
    xc = jnp.concatenate([buf, x], axis=1)
    out = sum(xc[:, j:j + t] * w[j] for j in range(CONV_W))
    return jax.nn.silu(out), xc[:, t:]


def gated_delta_chunked(q, k, v, g, beta, s0):
    bsz, t, h, dk = q.shape
    dv = v.shape[-1]
    c = DN_CHUNK if t % DN_CHUNK == 0 else t
    nc = t // c

    def blocks(x):
        return jnp.moveaxis(x.reshape((bsz, nc, c, h) + x.shape[3:]), 3, 2)

    q, k, v, g, beta = blocks(q), blocks(k), blocks(v), blocks(g), blocks(beta)
    gc = jnp.cumsum(g, axis=-1)
    incl = jnp.tril(jnp.ones((c, c), bool))
    strict = jnp.tril(jnp.ones((c, c), bool), -1)
    decay = jnp.exp(jnp.where(incl, gc[..., :, None] - gc[..., None, :], -jnp.inf))
    k_beta = k * beta[..., None]
    m = jnp.where(strict, jnp.einsum('...id,...jd->...ij', k_beta, k) * decay, 0.0)
    a = m + jnp.eye(c, dtype=m.dtype)
    rhs = jnp.concatenate([k_beta * jnp.exp(gc)[..., None], v * beta[..., None]], axis=-1)
    sol = lax.linalg.triangular_solve(a, rhs, left_side=True, lower=True, unit_diagonal=True)
    k_cum, v_u = sol[..., :dk], sol[..., dk:]
    qk = jnp.einsum('...id,...jd->...ij', q, k) * decay
    q_dec = q * jnp.exp(gc)[..., None]
    k_dec = k * jnp.exp(gc[..., -1:] - gc)[..., None]
    g_tot = jnp.exp(gc[..., -1])

    def step(s, xs):
        k_cum_n, v_u_n, qk_n, q_dec_n, k_dec_n, g_tot_n = xs
        v_new = v_u_n - jnp.einsum('bhcd,bhde->bhce', k_cum_n, s)
        o = jnp.einsum('bhcd,bhde->bhce', q_dec_n, s) + jnp.einsum('bhij,bhje->bhie', qk_n, v_new)
        s = s * g_tot_n[..., None, None] + jnp.einsum('bhcd,bhce->bhde', k_dec_n, v_new)
        return s, o

    xs = (jnp.moveaxis(k_cum, 1, 0), jnp.moveaxis(v_u, 1, 0), jnp.moveaxis(qk, 1, 0),
          jnp.moveaxis(q_dec, 1, 0), jnp.moveaxis(k_dec, 1, 0), jnp.moveaxis(g_tot, 1, 0))
    s_final, o = lax.scan(step, s0, xs)
    o = jnp.transpose(o, (1, 0, 3, 2, 4)).reshape(bsz, t, h, dv)
    return o, s_final


def parallel_mixers(h, w_in, attn_sinks, conv_w, dn_a_log, dn_dt_bias, dn_out_norm,
                    w_branch_a, w_branch_b, w_out, swa_k_buf, swa_v_buf, conv_buf, delta_state):
    bsz, t, _ = h.shape
    qa, ka, va, qkvb, zb, ab, bb, ga, gb = split_columns(h @ w_in)
    ka = ka.reshape(bsz, t, A_KV_HEADS, A_HEAD_DIM)
    va = va.reshape(bsz, t, A_KV_HEADS, A_HEAD_DIM)
    if swa_k_buf is None:
        oa, new_k, new_v = swa_prompt(qa, ka, va, attn_sinks)
    else:
        oa, new_k, new_v = swa_sample(qa, ka, va, swa_k_buf, swa_v_buf, attn_sinks)
    if conv_buf is None:
        conv_buf = jnp.zeros((bsz, CONV_W - 1, CONV_DIM), h.dtype)
    xb, new_conv = causal_short_conv(qkvb, conv_buf, conv_w)
    qb, kb, vb = jnp.split(xb.astype(jnp.float32), [B_HEADS * B_KEY_DIM, 2 * B_HEADS * B_KEY_DIM], axis=-1)
    qb = l2_normalize(qb.reshape(bsz, t, B_HEADS, B_KEY_DIM)) * (B_KEY_DIM ** -0.5)
    kb = l2_normalize(kb.reshape(bsz, t, B_HEADS, B_KEY_DIM))
    vb = vb.reshape(bsz, t, B_HEADS, B_VAL_DIM)
    g = -jnp.exp(dn_a_log.astype(jnp.float32)) * jax.nn.softplus(ab.astype(jnp.float32) + dn_dt_bias.astype(jnp.float32))
    beta = jax.nn.sigmoid(bb.astype(jnp.float32))
    if delta_state is None:
        s0 = jnp.zeros((bsz, B_HEADS, B_KEY_DIM, B_VAL_DIM), jnp.float32)
    else:
        s0 = delta_state.astype(jnp.float32)
    ob, new_s = gated_delta_chunked(qb, kb, vb, g, beta, s0)
    ob = rms_norm(ob, dn_out_norm) * jax.nn.silu(zb.astype(jnp.float32).reshape(bsz, t, B_HEADS, B_VAL_DIM))
    ob = ob.reshape(bsz, t, B_HEADS * B_VAL_DIM).astype(h.dtype)
    merged = jax.nn.sigmoid(ga) * (oa @ w_branch_a) + jax.nn.sigmoid(gb) * (ob @ w_branch_b)
    return merged @ w_out, new_k, new_v, new_conv, new_s.astype(h.dtype)


def decoder_layer(x, swa_k_buf, swa_v_buf, conv_buf, delta_state,
                  ffn1_norm_pre, ffn1_norm_post, ffn1_w_up, ffn1_w_down,
                  mix_norm_pre, mix_norm_post, w_in, attn_sinks, conv_w, dn_a_log, dn_dt_bias,
                  dn_out_norm, w_branch_a, w_branch_b, w_out,
                  ffn2_norm_pre, ffn2_norm_post, ffn2_w_up, ffn2_w_down):
    x = x + 0.5 * rms_norm(swiglu_ffn(rms_norm(x, ffn1_norm_pre), ffn1_w_up, ffn1_w_down), ffn1_norm_post)
    m, nk, nv, nc, ns = parallel_mixers(rms_norm(x, mix_norm_pre), w_in, attn_sinks, conv_w, dn_a_log,
                                        dn_dt_bias, dn_out_norm, w_branch_a, w_branch_b, w_out,
                                        swa_k_buf, swa_v_buf, conv_buf, delta_state)
    x = x + rms_norm(m, mix_norm_post)
    x = x + 0.5 * rms_norm(swiglu_ffn(rms_norm(x, ffn2_norm_pre), ffn2_w_up, ffn2_w_down), ffn2_norm_post)
    return x, nk, nv, nc, ns


def setup_inputs(seed: int = 0) -> dict:
    key = jax.random.key(seed)
    ks = iter(jax.random.split(key, 32))

    def nrm(shape, scale=1.0):
        return scale * jax.random.normal(next(ks), shape, jnp.float32)

    def gain(n):
        return 1.0 + 0.02 * nrm((DEPTH, n))

    win_buf = min(WINDOW, PAST_LEN)
    dt = jnp.exp(jax.random.uniform(next(ks), (DEPTH, B_HEADS), jnp.float32, math.log(1e-3), math.log(1e-1)))
    return {
        'x_prompt': nrm((BATCH, SEQ, D_MODEL)),
        'x_sample': nrm((DEC_BATCH, DEC_SEQ, D_MODEL)),
        'cache_swa_k': nrm((DEPTH, DEC_BATCH, win_buf, A_KV_HEADS, A_HEAD_DIM)),
        'cache_swa_v': nrm((DEPTH, DEC_BATCH, win_buf, A_KV_HEADS, A_HEAD_DIM)),
        'state_conv': nrm((DEPTH, DEC_BATCH, CONV_W - 1, CONV_DIM)),
        'state_delta': nrm((DEPTH, DEC_BATCH, B_HEADS, B_KEY_DIM, B_VAL_DIM), 0.1),
        'ffn1_norm_pre': gain(D_MODEL),
        'ffn1_norm_post': gain(D_MODEL),
        'ffn1_w_up': nrm((DEPTH, D_MODEL, 2 * D_FF), D_MODEL ** -0.5),
        'ffn1_w_down': nrm((DEPTH, D_FF, D_MODEL), D_FF ** -0.5),
        'mix_norm_pre': gain(D_MODEL),
        'mix_norm_post': gain(D_MODEL),
        'w_in': nrm((DEPTH, D_MODEL, IN_DIM), D_MODEL ** -0.5),
        'attn_sinks': nrm((DEPTH, A_HEADS)),
        'conv_w': nrm((DEPTH, CONV_W, CONV_DIM), CONV_W ** -0.5),
        'dn_a_log': jnp.log(jax.random.uniform(next(ks), (DEPTH, B_HEADS), jnp.float32, 1.0, 16.0)),
        'dn_dt_bias': jnp.log(jnp.expm1(dt)),
        'dn_out_norm': gain(B_VAL_DIM),
        'w_branch_a': nrm((DEPTH, A_HEADS * A_HEAD_DIM, D_MODEL), (A_HEADS * A_HEAD_DIM) ** -0.5),
        'w_branch_b': nrm((DEPTH, B_HEADS * B_VAL_DIM, D_MODEL), (B_HEADS * B_VAL_DIM) ** -0.5),
        'w_out': nrm((DEPTH, D_MODEL, D_MODEL), D_MODEL ** -0.5),
        'ffn2_norm_pre': gain(D_MODEL),
        'ffn2_norm_post': gain(D_MODEL),
        'ffn2_w_up': nrm((DEPTH, D_MODEL, 2 * D_FF), D_MODEL ** -0.5),
        'ffn2_w_down': nrm((DEPTH, D_FF, D_MODEL), D_FF ** -0.5),
    }


def reference(x_prompt, x_sample, cache_swa_k, cache_swa_v, state_conv, state_delta,
              ffn1_norm_pre, ffn1_norm_post, ffn1_w_up, ffn1_w_down,
              mix_norm_pre, mix_norm_post, w_in, attn_sinks, conv_w, dn_a_log, dn_dt_bias,
              dn_out_norm, w_branch_a, w_branch_b, w_out,
              ffn2_norm_pre, ffn2_norm_post, ffn2_w_up, ffn2_w_down):
    yp, ys = x_prompt, x_sample
    pk, pv, pc, ps = [], [], [], []
    sk, sv, sc, ss = [], [], [], []
    for l in range(DEPTH):
        lw = (ffn1_norm_pre[l], ffn1_norm_post[l], ffn1_w_up[l], ffn1_w_down[l],
              mix_norm_pre[l], mix_norm_post[l], w_in[l], attn_sinks[l], conv_w[l], dn_a_log[l],
              dn_dt_bias[l], dn_out_norm[l], w_branch_a[l], w_branch_b[l], w_out[l],
              ffn2_norm_pre[l], ffn2_norm_post[l], ffn2_w_up[l], ffn2_w_down[l])
        yp, k1, v1, c1, s1 = decoder_layer(yp, None, None, None, None, *lw)
        ys, k2, v2, c2, s2 = decoder_layer(ys, cache_swa_k[l], cache_swa_v[l], state_conv[l], state_delta[l], *lw)
        pk.append(k1); pv.append(v1); pc.append(c1); ps.append(s1)
        sk.append(k2); sv.append(v2); sc.append(c2); ss.append(s2)
    return (yp, ys,
            jnp.stack(pk), jnp.stack(pv), jnp.stack(pc), jnp.stack(ps),
            jnp.stack(sk), jnp.stack(sv), jnp.stack(sc), jnp.stack(ss))
```

```cpp
#include <hip/hip_runtime.h>
#include <cstdio>
#include <cstdint>

constexpr int DM = 1024, NBATCH = 8, SEQ = 2048, DBATCH = 128, DSEQ = 8;
constexpr int MP = NBATCH * SEQ, MS = DBATCH * DSEQ, MROWS = MP + MS;
constexpr int FF = 2816, NUP = 2 * FF, CONVD = 1536, INDIM = 4872;
constexpr int NZ1 = 2816, NGATE = 2048;
constexpr float EPS = 1e-6f;
constexpr size_t O_Y = 0, O_KP = 17825792, O_VP = O_KP + 131072, O_CP = O_VP + 131072, O_DP = O_CP + 36864, O_KS = O_DP + 524288, O_VS = O_KS + 2097152,
                 O_CS = O_VS + 2097152, O_DS = O_CS + 589824, O_END = O_DS + 8388608;
static_assert(O_END == 31821824, "output size");

namespace pg8 {
#define PG8_LAS __attribute__((address_space(3)))
typedef unsigned short bf16_t;
typedef short bf16x8 __attribute__((ext_vector_type(8)));
typedef float f32x4 __attribute__((ext_vector_type(4)));
typedef unsigned u32x4 __attribute__((ext_vector_type(4)));
constexpr int BM = 256, BK = 64, HALF = 128, HTB = HALF * BK * 2  , STAGE_BYTES = 8 * HTB, NXCD = 8, WGM = 8;

__host__ __device__ __forceinline__ int lds_byte(int r, int c) { const int st = (r >> 4) * 2 + (c >> 5), rr = r & 15, cc = c & 31, ob = rr * 64 + cc * 2; return st * 1024 + (ob ^ (((ob >> 9) & 1) << 5)); }
__host__ __device__ __forceinline__ void stage_rc(int b, int& R, int& C) { const int st = b / 1024, sb = b % 1024, swz = sb ^ (((sb >> 9) & 1) << 5); R = (st >> 1) * 16 + swz / 64; C = (st & 1) * 32 + (swz % 64) / 2; }
__host__ __device__ __forceinline__ int perm32(int rho) { const int n = rho >> 4, i = rho & 15; return 8 * (i >> 2) + 4 * n + (i & 3); }

struct Unit { int pm, pn, br; };
struct Gemm { const bf16_t* A0; const bf16_t* A1; const bf16_t* B0; const bf16_t* B1; int K; int nt; };

struct StaticOrder {
    int nM, nN, nwg, G, c;
    __device__ void init(int M, int N, int G_, int c_) { nM = M / BM; nN = N / BM; nwg = nM * nN; G = G_; c = c_; }
    __device__ void map(int L, Unit& u) const {
        int wgid = L; { const int q = nwg / NXCD, r = nwg % NXCD, xcd = wgid % NXCD, off = wgid / NXCD; wgid = (xcd < r ? xcd * (q + 1) : r * (q + 1) + (xcd - r) * q) + off; }
        const int nig = WGM * nN, gid = wgid / nig, fm = gid * WGM, gsz = (nM - fm) < WGM ? (nM - fm) : WGM;
        u.pm = fm + ((wgid % nig) % gsz); u.pn = (wgid % nig) / gsz; u.br = 0;
    }
    __device__ bool next(int i, Unit& u) const { const long L = (long)i * G + c; if (L >= nwg) return false; map((int)L, u); return true; }
};
struct PairOrder {
    StaticOrder so;
    __device__ bool next(int i, Unit& u) const { const long L = (long)(i >> 1) * so.G + so.c; if (L >= so.nwg) return false; so.map((int)L, u); u.br = i & 1; return true; }
};

typedef float f32x2_cv __attribute__((ext_vector_type(2))); typedef __bf16 bf16x2_cv __attribute__((ext_vector_type(2)));
__device__ __forceinline__ unsigned cvt_pk_bf16(float lo, float hi) { f32x2_cv v = {lo, hi}; bf16x2_cv b = __builtin_convertvector(v, bf16x2_cv); return __builtin_bit_cast(unsigned, b); }
__device__ __forceinline__ float bflo(unsigned w) { return __builtin_bit_cast(float, w << 16); }
__device__ __forceinline__ float bfhi(unsigned w) { return __builtin_bit_cast(float, w & 0xffff0000u); }
__device__ __forceinline__ float sigm(float x) { return __builtin_amdgcn_rcpf(1.0f + __expf(-x)); }

typedef f32x4 Acc[2][2][4][2];

struct EpiSwiglu {
    static constexpr bool PERM = true;
    bf16_t* O; int ldc;
    __device__ __forceinline__ bool keep(const Unit&) const { return false; }
    __device__ __forceinline__ void operator()(Acc& acc, const Unit& u, int wr, int wc, int fr, int fq) const {
        const int row0 = u.pm * BM + wr * 64 + fr, col0 = u.pn * HALF + wc * 32 + 8 * fq;
#pragma unroll
        for (int ai = 0; ai < 2; ++ai)
#pragma unroll
            for (int m = 0; m < 4; ++m) {
                float o[8];
#pragma unroll
                for (int n = 0; n < 2; ++n)
#pragma unroll
                    for (int j = 0; j < 4; ++j) { const float g = acc[ai][0][m][n][j], up = acc[ai][1][m][n][j]; o[4 * n + j] = g * sigm(g) * up; }
                u32x4 w; w.x = cvt_pk_bf16(o[0], o[1]); w.y = cvt_pk_bf16(o[2], o[3]); w.z = cvt_pk_bf16(o[4], o[5]); w.w = cvt_pk_bf16(o[6], o[7]);
                *(u32x4*)(O + (size_t)(row0 + ai * HALF + m * 16) * ldc + col0) = w;
            }
    }
};
struct EpiF32 {
    static constexpr bool PERM = false;
    float* O; int ldc;
    __device__ __forceinline__ bool keep(const Unit&) const { return false; }
    __device__ __forceinline__ void operator()(Acc& acc, const Unit& u, int wr, int wc, int fr, int fq) const {
        const int row0 = u.pm * BM + wr * 64 + fr, col0 = u.pn * BM + wc * 32 + 4 * fq;
#pragma unroll
        for (int ai = 0; ai < 2; ++ai)
#pragma unroll
            for (int m = 0; m < 4; ++m) { float* rowp = O + (size_t)(row0 + ai * HALF + m * 16) * ldc + col0;
#pragma unroll
                for (int bj = 0; bj < 2; ++bj)
#pragma unroll
                    for (int n = 0; n < 2; ++n) *(f32x4*)(rowp + bj * HALF + n * 16) = acc[ai][bj][m][n]; }
    }
};
template <int ACT  > struct EpiBf16Z {
    static constexpr bool PERM = true;
    bf16_t* O0; bf16_t* O1; bf16_t* O2; int ld0, ld1, ld2, t1, t2;
    __device__ __forceinline__ bool keep(const Unit&) const { return false; }
    __device__ __forceinline__ void operator()(Acc& acc, const Unit& u, int wr, int wc, int fr, int fq) const {
        bf16_t* base; int ld, pn = u.pn;
        if (pn < t1) { base = O0; ld = ld0; } else if (pn < t2) { base = O1; ld = ld1; pn -= t1; } else { base = O2; ld = ld2; pn -= t2; }
        const int row0 = u.pm * BM + wr * 64 + fr, col0 = pn * BM + wc * 32 + 8 * fq;
#pragma unroll
        for (int ai = 0; ai < 2; ++ai)
#pragma unroll
            for (int m = 0; m < 4; ++m) { bf16_t* rowp = base + (size_t)(row0 + ai * HALF + m * 16) * ld + col0;
#pragma unroll
                for (int bj = 0; bj < 2; ++bj) { f32x4 v0 = acc[ai][bj][m][0], v1 = acc[ai][bj][m][1];
                    if (ACT == 1) {
#pragma unroll
                        for (int j = 0; j < 4; ++j) { v0[j] = sigm(v0[j]); v1[j] = sigm(v1[j]); } }
                    u32x4 w; w.x = cvt_pk_bf16(v0[0], v0[1]); w.y = cvt_pk_bf16(v0[2], v0[3]); w.z = cvt_pk_bf16(v1[0], v1[1]); w.w = cvt_pk_bf16(v1[2], v1[3]);
                    *(u32x4*)(rowp + bj * HALF) = w; } }
    }
};
struct EpiMerge {
    static constexpr bool PERM = true;
    const bf16_t* SG; bf16_t* O;
    __device__ __forceinline__ bool keep(const Unit& u) const { return u.br == 0; }
    __device__ __forceinline__ void operator()(Acc& acc, const Unit& u, int wr, int wc, int fr, int fq) const {
        const int row0 = u.pm * BM + wr * 64 + fr, col0 = u.pn * BM + wc * 32 + 8 * fq;
#pragma unroll
        for (int ai = 0; ai < 2; ++ai)
#pragma unroll
            for (int m = 0; m < 4; ++m) { const size_t row = (size_t)(row0 + ai * HALF + m * 16);
#pragma unroll
                for (int bj = 0; bj < 2; ++bj) {
                    const u32x4 sb = *(const u32x4*)(SG + row * 2048 + 1024 + col0 + bj * HALF);
                    float b[8] = {bflo(sb.x), bfhi(sb.x), bflo(sb.y), bfhi(sb.y), bflo(sb.z), bfhi(sb.z), bflo(sb.w), bfhi(sb.w)};
                    if (u.br == 0) {
                        const u32x4 sa = *(const u32x4*)(SG + row * 2048 + col0 + bj * HALF);
                        float a[8] = {bflo(sa.x), bfhi(sa.x), bflo(sa.y), bfhi(sa.y), bflo(sa.z), bfhi(sa.z), bflo(sa.w), bfhi(sa.w)};
#pragma unroll
                        for (int n = 0; n < 2; ++n)
#pragma unroll
                            for (int j = 0; j < 4; ++j) acc[ai][bj][m][n][j] *= a[4 * n + j] / b[4 * n + j];
                    } else {
                        float o[8];
#pragma unroll
                        for (int n = 0; n < 2; ++n)
#pragma unroll
                            for (int j = 0; j < 4; ++j) o[4 * n + j] = acc[ai][bj][m][n][j] * b[4 * n + j];
                        u32x4 w; w.x = cvt_pk_bf16(o[0], o[1]); w.y = cvt_pk_bf16(o[2], o[3]); w.z = cvt_pk_bf16(o[4], o[5]); w.w = cvt_pk_bf16(o[6], o[7]);
                        *(u32x4*)(O + row * 1024 + col0 + bj * HALF) = w;
                    }
                } }
    }
};

template <class Epi, class Sched, bool ALIGN_EPI = false, bool SP2 = false>
__device__ __forceinline__ void gemm_phase(PG8_LAS unsigned char* lds, const Gemm g, const Sched& S, const Epi& E) {
    int tid_ = threadIdx.x; asm volatile("" : "+v"(tid_));
    const int tid = tid_, wid = __builtin_amdgcn_readfirstlane(tid >> 6), lane = tid & 63, wr = wid >> 2, wc = wid & 3, fr = lane & 15, fq = lane >> 4;
    const int K = g.K, nt = g.nt;
    unsigned voffA[2], voffB[2];
#pragma unroll
    for (int i = 0; i < 2; ++i) { int R, C; stage_rc(tid * 16 + i * 8192, R, C); const int Rb = Epi::PERM ? ((R & ~31) + perm32(R & 31)) : R;
        voffA[i] = (unsigned)(R * K + C) * 2u; voffB[i] = (unsigned)(Rb * K + C) * 2u; }
    const size_t kstep = (size_t)(BK * 2);
    const size_t hstep = (size_t)HALF * K * 2;
    const size_t tstep = 2 * hstep;
    const unsigned ldsw = (unsigned)wid * 1024u;
    const int aoff = lds_byte(wr * 64 + fr, fq * 8), boff = lds_byte(wc * 32 + fr, fq * 8);
#define PG8_SA(b, h) (((b) * 2 + (h)) * HTB)
#define PG8_SB(b, h) ((4 + (b) * 2 + (h)) * HTB)
#define PG8_STAGE(bufoff, gbase, voff) do { _Pragma("unroll") for (int _i = 0; _i < 2; ++_i) \
        __builtin_amdgcn_global_load_lds((const unsigned*)((const char*)(gbase) + (voff)[_i]), (PG8_LAS unsigned*)(lds + (bufoff) + ldsw + _i * 8192), 16, 0, 0); } while (0)
#define PG8_LDA(dst, b, h) do { _Pragma("unroll") for (int m = 0; m < 4; ++m) _Pragma("unroll") for (int k = 0; k < 2; ++k) dst[m][k] = *(const PG8_LAS bf16x8*)(lds + PG8_SA(b, h) + aoff + m * 2048 + k * 1024); } while (0)
#define PG8_LDB(dst, b, h) do { _Pragma("unroll") for (int n = 0; n < 2; ++n) _Pragma("unroll") for (int k = 0; k < 2; ++k) dst[n][k] = *(const PG8_LAS bf16x8*)(lds + PG8_SB(b, h) + boff + n * 2048 + k * 1024); } while (0)
#define PG8_MMA(ai, bj, At, Bt) do { __builtin_amdgcn_s_setprio(1); _Pragma("unroll") for (int m = 0; m < 4; ++m) _Pragma("unroll") for (int n = 0; n < 2; ++n) _Pragma("unroll") for (int k = 0; k < 2; ++k) \
        acc[ai][bj][m][n] = __builtin_amdgcn_mfma_f32_16x16x32_bf16(Bt[n][k], At[m][k], acc[ai][bj][m][n], 0, 0, 0); __builtin_amdgcn_s_setprio(0); } while (0)
#define PG8_WAIT_V(n) asm volatile("s_waitcnt vmcnt(" #n ")" ::: "memory")
#define PG8_WAIT_L(n) asm volatile("s_waitcnt lgkmcnt(" #n ")" ::: "memory")
#define PG8_BAR __builtin_amdgcn_s_barrier()
#define PG8_SCHED __builtin_amdgcn_sched_barrier(0)
    Unit cur, nxt; int ui = 0;
    if (!S.next(0, cur)) return;
    f32x4 acc[2][2][4][2];
#pragma unroll
    for (int a = 0; a < 2; ++a)
#pragma unroll
        for (int b = 0; b < 2; ++b)
#pragma unroll
            for (int m = 0; m < 4; ++m)
#pragma unroll
                for (int n = 0; n < 2; ++n) acc[a][b][m][n] = (f32x4){0.f, 0.f, 0.f, 0.f};
    bf16x8 At[4][2], B0[2][2], B1[2][2];
    const char* cA = (const char*)(cur.br ? g.A1 : g.A0) + (size_t)cur.pm * tstep; const char* cB = (const char*)(cur.br ? g.B1 : g.B0) + (size_t)cur.pn * tstep;
    if constexpr (SP2) {
        PG8_STAGE(PG8_SB(0, 0), cB, voffB); PG8_STAGE(PG8_SB(0, 1), cB + hstep, voffB); PG8_STAGE(PG8_SA(0, 0), cA, voffA); PG8_STAGE(PG8_SA(0, 1), cA + hstep, voffA);
        if (wr == 1) PG8_BAR;
        PG8_WAIT_V(2); PG8_BAR;
        PG8_STAGE(PG8_SB(1, 0), cB + kstep, voffB); PG8_STAGE(PG8_SA(1, 0), cA + kstep, voffA); PG8_STAGE(PG8_SB(1, 1), cB + hstep + kstep, voffB);
        PG8_WAIT_V(6); PG8_BAR;
    } else {
        PG8_STAGE(PG8_SB(0, 0), cB, voffB); PG8_STAGE(PG8_SA(0, 0), cA, voffA); PG8_STAGE(PG8_SB(0, 1), cB + hstep, voffB); PG8_STAGE(PG8_SA(0, 1), cA + hstep, voffA);
        if (wr == 1) PG8_BAR;
        PG8_WAIT_V(4); PG8_BAR;
        PG8_STAGE(PG8_SB(1, 0), cB + kstep, voffB); PG8_STAGE(PG8_SA(1, 0), cA + kstep, voffA); PG8_STAGE(PG8_SB(1, 1), cB + hstep + kstep, voffB);
        PG8_WAIT_V(6); PG8_BAR;
    }
    for (;;) {
        const bool has_next = S.next(ui + 1, nxt);
        const char* nA = has_next ? (const char*)(nxt.br ? g.A1 : g.A0) + (size_t)nxt.pm * tstep : cA; const char* nB = has_next ? (const char*)(nxt.br ? g.B1 : g.B0) + (size_t)nxt.pn * tstep : cB;
        for (int t = 0; t < nt; t += 2) {
            const bool last = (t == nt - 2);
            const char* a1 = cA + (size_t)(t + 1) * kstep;
            const char* a2 = last ? nA : cA + (size_t)(t + 2) * kstep; const char* b2 = last ? nB : cB + (size_t)(t + 2) * kstep;
            const char* a3 = a2 + kstep; const char* b3 = b2 + kstep;
            if constexpr (SP2) {
            PG8_LDB(B0, 0, 0); PG8_LDB(B1, 0, 1); PG8_SCHED; PG8_LDA(At, 0, 0); PG8_STAGE(PG8_SA(1, 1), a1 + hstep, voffA);
            PG8_WAIT_V(8); PG8_WAIT_L(0); PG8_BAR; PG8_MMA(0, 0, At, B0); PG8_MMA(0, 1, At, B1); PG8_BAR; PG8_SCHED;
            PG8_LDA(At, 0, 1); PG8_STAGE(PG8_SB(0, 0), b2, voffB); PG8_STAGE(PG8_SB(0, 1), b2 + hstep, voffB); PG8_STAGE(PG8_SA(0, 0), a2, voffA);
            PG8_WAIT_V(8); PG8_WAIT_L(0); PG8_BAR; PG8_MMA(1, 0, At, B0); PG8_MMA(1, 1, At, B1); PG8_BAR; PG8_SCHED;
            PG8_LDB(B0, 1, 0); PG8_LDB(B1, 1, 1); PG8_SCHED; PG8_LDA(At, 1, 0); PG8_STAGE(PG8_SA(0, 1), a2 + hstep, voffA);
            PG8_WAIT_V(8); PG8_WAIT_L(0); PG8_BAR; PG8_MMA(0, 0, At, B0); PG8_MMA(0, 1, At, B1); PG8_BAR; PG8_SCHED;
            PG8_LDA(At, 1, 1); PG8_STAGE(PG8_SB(1, 0), b3, voffB); PG8_STAGE(PG8_SB(1, 1), b3 + hstep, voffB); PG8_STAGE(PG8_SA(1, 0), a3, voffA);
            PG8_WAIT_V(8); PG8_WAIT_L(0); PG8_BAR; PG8_MMA(1, 0, At, B0); PG8_MMA(1, 1, At, B1); PG8_BAR; PG8_SCHED;
            } else {
            PG8_LDB(B0, 0, 0); PG8_SCHED; PG8_LDA(At, 0, 0); PG8_STAGE(PG8_SA(1, 1), a1 + hstep, voffA);
            PG8_WAIT_L(8); PG8_BAR; PG8_WAIT_L(0); PG8_MMA(0, 0, At, B0); PG8_BAR; PG8_SCHED;
            PG8_LDB(B1, 0, 1); PG8_STAGE(PG8_SB(0, 0), b2, voffB);
            PG8_BAR; PG8_WAIT_L(0); PG8_MMA(0, 1, At, B1); PG8_BAR;
            PG8_LDA(At, 0, 1); PG8_STAGE(PG8_SA(0, 0), a2, voffA);
            PG8_BAR; PG8_WAIT_L(0); PG8_MMA(1, 0, At, B0); PG8_BAR; PG8_SCHED;
            PG8_STAGE(PG8_SB(0, 1), b2 + hstep, voffB);
            PG8_WAIT_V(6); PG8_BAR; PG8_MMA(1, 1, At, B1); PG8_BAR;
            PG8_LDB(B0, 1, 0); PG8_SCHED; PG8_LDA(At, 1, 0); PG8_STAGE(PG8_SA(0, 1), a2 + hstep, voffA);
            PG8_WAIT_L(8); PG8_BAR; PG8_WAIT_L(0); PG8_MMA(0, 0, At, B0); PG8_BAR; PG8_SCHED;
            PG8_LDB(B1, 1, 1); PG8_STAGE(PG8_SB(1, 0), b3, voffB);
            PG8_BAR; PG8_WAIT_L(0); PG8_MMA(0, 1, At, B1); PG8_BAR;
            PG8_LDA(At, 1, 1); PG8_STAGE(PG8_SA(1, 0), a3, voffA);
            PG8_BAR; PG8_WAIT_L(0); PG8_MMA(1, 0, At, B0); PG8_BAR; PG8_SCHED;
            PG8_STAGE(PG8_SB(1, 1), b3 + hstep, voffB);
            PG8_WAIT_V(6); PG8_BAR; PG8_MMA(1, 1, At, B1); PG8_BAR;
            }
        }
        if constexpr (ALIGN_EPI) { if (wr == 0) PG8_BAR; }
        E(acc, cur, wr, wc, fr, fq);
        if (!has_next) break;
        if (!E.keep(cur)) {
#pragma unroll
        for (int a = 0; a < 2; ++a)
#pragma unroll
            for (int b = 0; b < 2; ++b)
#pragma unroll
                for (int m = 0; m < 4; ++m)
#pragma unroll
                    for (int n = 0; n < 2; ++n) acc[a][b][m][n] = (f32x4){0.f, 0.f, 0.f, 0.f};
        }
        cur = nxt; cA = nA; cB = nB; ++ui;
        if constexpr (ALIGN_EPI) { if (wr == 1) PG8_BAR; }
    }
    PG8_WAIT_V(0);
    if constexpr (!ALIGN_EPI) { if (wr == 0) PG8_BAR; }
    PG8_BAR;
#undef PG8_SA
#undef PG8_SB
#undef PG8_STAGE
#undef PG8_LDA
#undef PG8_LDB
#undef PG8_MMA
#undef PG8_WAIT_V
#undef PG8_WAIT_L
#undef PG8_BAR
#undef PG8_SCHED
}
}
#define GAS __attribute__((address_space(1)))
#define LAS __attribute__((address_space(3)))
typedef unsigned short bf16;
typedef unsigned v4u __attribute__((ext_vector_type(4)));
typedef float f32x4 __attribute__((ext_vector_type(4)));
typedef short bf16x8 __attribute__((ext_vector_type(8)));
typedef GAS unsigned gu32;
typedef GAS unsigned long long gu64;
#define RLX_AGENT __ATOMIC_RELAXED, __HIP_MEMORY_SCOPE_AGENT
#define LDS_WAIT() asm volatile("s_waitcnt lgkmcnt(0)" ::: "memory")
#define VM_WAIT() asm volatile("s_waitcnt vmcnt(0)" ::: "memory")
__device__ __forceinline__ unsigned long long rt() { return __builtin_amdgcn_s_memrealtime(); }
__device__ __forceinline__ unsigned f2bf(float f) { unsigned u = __builtin_bit_cast(unsigned, f); return (u + 0x7fffu + ((u >> 16) & 1u)) >> 16; }
__device__ __forceinline__ unsigned pk2(float lo, float hi) { return f2bf(lo) | (f2bf(hi) << 16); }

#define XB_TMO      128
#define XB_XCNT(j)  (256  + 64 * (j))
#define XB_XSUB(j)  (1280 + 64 * (j))
#define XB_XGEN(j)  (2304 + 64 * (j))
#define XB_TOP      3328
#define XB_TOPGEN   3392
#define XCD_BAR_WORDS 3456
#define XB_SPIN_CAP (1u << 18)

__device__ __forceinline__ unsigned xb_ld(unsigned* p)              { return __hip_atomic_load(p, __ATOMIC_RELAXED, __HIP_MEMORY_SCOPE_AGENT); }
__device__ __forceinline__ unsigned xb_add(unsigned* p, unsigned v) { return __hip_atomic_fetch_add(p, v, __ATOMIC_RELAXED, __HIP_MEMORY_SCOPE_AGENT); }
__device__ __forceinline__ unsigned xb_xcc_id() { return (unsigned)__builtin_amdgcn_s_getreg((3 << 11) | 20) & 0xFu; }
#define XB_SPIN(cond, bar) do { unsigned _sp = 0; while (cond) { __builtin_amdgcn_s_sleep(1); \
    if ((++_sp & 255u) == 0u) { if (xb_ld(&(bar)[XB_TMO])) break; if (_sp > XB_SPIN_CAP) { atomicAdd(&(bar)[XB_TMO], 1u); break; } } } } while (0)

struct XcdBarrier {
    unsigned* bar; unsigned x;
    volatile LAS unsigned* st;
};

__device__ __forceinline__ XcdBarrier xcd_barrier_post(unsigned* bar, volatile LAS unsigned* st) {
    XcdBarrier b; b.bar = bar; b.x = xb_xcc_id(); b.st = st;
    if (threadIdx.x == 0) (void)xb_add(&bar[XB_XCNT(b.x)], 1u);
    return b;
}
__device__ __forceinline__ void xcd_barrier_complete(unsigned* bar, unsigned x, unsigned& nloc, unsigned& nx) {
    const unsigned G = gridDim.x * gridDim.y * gridDim.z;
    unsigned sum, cnt, mine, sp = 0u;
    for (;;) {
        sum = 0u; cnt = 0u; mine = 0u;
#pragma unroll
        for (unsigned j = 0; j < 16; ++j) { const unsigned c = xb_ld(&bar[XB_XCNT(j)]); sum += c; cnt += (c > 0u) ? 1u : 0u; mine = (j == x) ? c : mine; }
        if (sum == G) break;
        __builtin_amdgcn_s_sleep(1);
        if ((++sp & 255u) == 0u) { if (xb_ld(&bar[XB_TMO])) break; if (sp > XB_SPIN_CAP) { atomicAdd(&bar[XB_TMO], 1u); break; } }
    }
    nloc = mine > 0u ? mine : 1u; nx = cnt > 0u ? cnt : 1u;
}

__device__ __forceinline__ void xcd_barrier(const XcdBarrier& b) {
    asm volatile("s_waitcnt vmcnt(0)" ::: "memory");
    __syncthreads();
    if (threadIdx.x == 0) {
        unsigned* bar = b.bar;
        __builtin_amdgcn_s_waitcnt(0);
        unsigned nloc = b.st[0], nx = b.st[1];
        if (nloc == 0u) { xcd_barrier_complete(bar, b.x, nloc, nx); b.st[0] = nloc; b.st[1] = nx; }
        const unsigned old = xb_add(&bar[XB_XSUB(b.x)], 1u);
        const unsigned gen = old / nloc;
        if (old + 1u == (gen + 1u) * nloc) {
            __builtin_amdgcn_fence(__ATOMIC_RELEASE, "");
            asm volatile("s_waitcnt vmcnt(0)" ::: "memory");
            const unsigned og = xb_add(&bar[XB_TOP], 1u);
            const unsigned tg = og / nx;
            if (og + 1u == (tg + 1u) * nx) xb_add(&bar[XB_TOPGEN], 1u);
            else XB_SPIN(xb_ld(&bar[XB_TOPGEN]) == tg, bar);
            __builtin_amdgcn_fence(__ATOMIC_ACQUIRE, "");
            xb_add(&bar[XB_XGEN(b.x)], 1u);
            asm volatile("s_waitcnt vmcnt(0)" ::: "memory");
        } else {
            XB_SPIN(xb_ld(&bar[XB_XGEN(b.x)]) == gen, bar);
            __builtin_amdgcn_fence(__ATOMIC_ACQUIRE, "");
            asm volatile("s_waitcnt vmcnt(0)" ::: "memory");
        }
    }
    __syncthreads();
}
typedef unsigned v2u __attribute__((ext_vector_type(2)));

constexpr size_t MiB = 1u << 20;
constexpr size_t WS_CTL = 0, CTL_ZERO_BYTES = 64 * 1024;
constexpr size_t WS_W = 1 * MiB;
constexpr size_t W_UP = 0, W_DOWN = (size_t)NUP * DM * 2;
constexpr size_t W_IN1 = 0, W_G = (size_t)NZ1 * DM * 2, W_A = W_G + (size_t)NGATE * DM * 2, W_B = W_A + (size_t)DM * 512 * 2, W_O = W_B + (size_t)DM * 512 * 2;
static_assert(W_DOWN + (size_t)DM * FF * 2 <= 17 * MiB && W_O + (size_t)DM * DM * 2 <= 17 * MiB, "weight region");
constexpr size_t WS_XN = 18 * MiB;
constexpr size_t WS_RA = 52 * MiB;
constexpr size_t RA_ZA = 0, RA_ZC = (size_t)MROWS * 768 * 2, RA_ZZ = RA_ZC + (size_t)MROWS * 1536 * 2;
constexpr size_t WS_RB = 146 * MiB;
constexpr size_t PREP_UNIT = 73728, PU_KC = 0, PU_QD = 16384, PU_KD = 32768, PU_VU = 49152, PU_QK = 65536;
constexpr size_t WS_RC = 218 * MiB;
constexpr size_t WS_GB = 252 * MiB;
constexpr size_t WS_GT = WS_GB + 640 * 1024;
constexpr size_t WS_WAB = 253 * MiB;
constexpr size_t WS_END = 254 * MiB;
static_assert(WS_XN + (size_t)MROWS * DM * 2 <= WS_RA && WS_RA + (size_t)MROWS * 2816 * 2 <= WS_RB && WS_RB + 1024 * PREP_UNIT <= WS_RC && (size_t)MROWS * DM * 4 <= 72 * MiB &&
              WS_RC + 2 * (size_t)MROWS * 512 * 2 <= WS_GB && (size_t)MROWS * 32 <= 640 * 1024 && (size_t)MP * 512 * 4 <= (size_t)MROWS * 1536 * 2, "d_ws map");
constexpr int CW_BAR = 1024;

constexpr int RING_BYTES = 131072;
constexpr int PREP_HALF = 69888;
constexpr int MISC_OFF = 2 * PREP_HALF;
constexpr int LDS_BYTES = MISC_OFF + 256;
constexpr int NWAVES = 8;

struct Frame {
    LAS unsigned char* lds;
    int tid, lane, wave, vcu, G;
    float* out; unsigned char* ws;
};

__device__ __forceinline__ float bf2f(unsigned short b) { return __builtin_bit_cast(float, (unsigned)b << 16); }
__device__ __forceinline__ float blo(unsigned w) { return __builtin_bit_cast(float, w << 16); }
__device__ __forceinline__ float bhi(unsigned w) { return __builtin_bit_cast(float, w & 0xffff0000u); }
__device__ __forceinline__ float wave_sum(float v) {
#pragma unroll
    for (int o = 1; o < 64; o <<= 1) v += __shfl_xor(v, o);
    return v;
}
__device__ __forceinline__ float siluf(float x) { return x * __builtin_amdgcn_rcpf(1.0f + __expf(-x)); }
__device__ __forceinline__ float sigmf(float x) { return __builtin_amdgcn_rcpf(1.0f + __expf(-x)); }
#define MFMA16(a, b, c) __builtin_amdgcn_mfma_f32_16x16x32_bf16((a), (b), (c), 0, 0, 0)
#define LDS_FENCE() asm volatile("s_waitcnt lgkmcnt(0)" ::: "memory")

__device__ __forceinline__ void transpose_item(const float* W, int K, int N, bf16* WT, int k0, int sc0, int dr0, LAS float* scr, int lane) {
#pragma unroll 8
    for (int i = 0; i < 32; ++i) { const int kk = 2 * i + (lane >> 5); scr[kk * 33 + (lane & 31)] = W[(size_t)(k0 + kk) * N + sc0 + (lane & 31)]; }
    LDS_WAIT(); asm volatile("" ::: "memory");
    const int c = lane & 7;
#pragma unroll
    for (int j = 0; j < 4; ++j) { const int n = (lane >> 3) + 8 * j; const LAS float* s = scr + (8 * c) * 33 + n;
        v4u o; o.x = pk2(s[0 * 33], s[1 * 33]); o.y = pk2(s[2 * 33], s[3 * 33]); o.z = pk2(s[4 * 33], s[5 * 33]); o.w = pk2(s[6 * 33], s[7 * 33]);
        *(GAS v4u*)(WT + (size_t)(dr0 + n) * K + k0 + 8 * c) = o; }
    LDS_WAIT(); asm volatile("" ::: "memory");
}
__device__ __forceinline__ void conv_up(const Frame& F, const float* W, bf16* WT, LAS float* scr, int it) {
    const int kb = it / 176, nb = it % 176, sc0 = nb * 32;
    const int j = sc0 < FF ? sc0 : sc0 - FF; const int dr0 = 256 * (j >> 7) + (sc0 < FF ? 0 : 128) + (j & 127);
    transpose_item(W, DM, NUP, WT, kb * 64, sc0, dr0, scr, F.lane);
}
__device__ __forceinline__ void conv_plain(const Frame& F, const float* W, int K, int N, int ncols, int scoff, bf16* WT, LAS float* scr, int it) {
    const int nblk = ncols / 32, kb = it / nblk, nb = it % nblk;
    transpose_item(W, K, N, WT, kb * 64, scoff + nb * 32, nb * 32, scr, F.lane);
}
__device__ __forceinline__ void convert_ffn_weights(const Frame& F, const float* wup, const float* wdown, int scr_base) {
    LAS float* scr = (LAS float*)(F.lds + scr_base + F.wave * 8448);
    bf16* wb = (bf16*)(F.ws + WS_W);
    const int gw = F.vcu * NWAVES + F.wave, NGW = F.G * NWAVES;
    constexpr int I_UP = 16 * 176, I_DN = 44 * 32;
    for (int it = gw; it < I_UP + I_DN; it += NGW) {
        if (it < I_UP) conv_up(F, wup, wb + W_UP / 2, scr, it);
        else conv_plain(F, wdown, FF, DM, DM, 0, wb + W_DOWN / 2, scr, it - I_UP);
    }
}
__device__ __forceinline__ void convert_mix_weights(const Frame& F, const float* w_in, const float* w_a, const float* w_b, const float* w_o, int scr_base) {
    LAS float* scr = (LAS float*)(F.lds + scr_base + F.wave * 8448);
    bf16* wb = (bf16*)(F.ws + WS_W);
    const int gw = F.vcu * NWAVES + F.wave, NGW = F.G * NWAVES;
    constexpr int I1 = 16 * 88, I2 = 16 * 64, I3 = 8 * 32, I4 = 16 * 32;
    for (int it = gw; it < I1 + I2 + 2 * I3 + I4; it += NGW) {
        int r = it;
        if (r < I1) { conv_plain(F, w_in, DM, INDIM, NZ1, 0, wb + W_IN1 / 2, scr, r); continue; } r -= I1;
        if (r < I2) { conv_plain(F, w_in, DM, INDIM, NGATE, 2824, wb + W_G / 2, scr, r); continue; } r -= I2;
        if (r < I3) { conv_plain(F, w_a, 512, DM, DM, 0, wb + W_A / 2, scr, r); continue; } r -= I3;
        if (r < I3) { conv_plain(F, w_b, 512, DM, DM, 0, wb + W_B / 2, scr, r); continue; } r -= I3;
        conv_plain(F, w_o, DM, DM, DM, 0, wb + W_O / 2, scr, r);
    }
}

template <int MODE> __device__ __forceinline__ void rowwise(const Frame& F, const float* wpost, const float* wpre, const float* xp, const float* xs, const float* a_log, const float* dt_bias) {
    const int gw = F.vcu * NWAVES + F.wave, NGW = F.G * NWAVES, lane = F.lane;
    float* Y = F.out + O_Y; const float* MBp = (const float*)(F.ws + WS_RB); bf16* XN = (bf16*)(F.ws + WS_XN);
    f32x4 wq[4], wp[4];
#pragma unroll
    for (int j = 0; j < 4; ++j) { if (MODE != 0) wq[j] = *(const f32x4*)(wpost + 4 * lane + 256 * j); if (MODE != 3) wp[j] = *(const f32x4*)(wpre + 4 * lane + 256 * j); }
    const LAS float* wab = (const LAS float*)F.lds;
    float alog = 0.f, dtb = 0.f;
    if (MODE == 1) { alog = __expf(a_log[lane & 3]); dtb = dt_bias[lane & 3]; }
    for (int m = gw; m < MROWS; m += NGW) {
        f32x4 x[4];
        if (MODE == 0 || MODE == 1) { const float* xr = (m < MP) ? xp + (size_t)m * DM : xs + (size_t)(m - MP) * DM;
#pragma unroll
            for (int j = 0; j < 4; ++j) x[j] = *(const f32x4*)(xr + 4 * lane + 256 * j);
        } else {
#pragma unroll
            for (int j = 0; j < 4; ++j) x[j] = *(const f32x4*)(Y + (size_t)m * DM + 4 * lane + 256 * j);
        }
        if (MODE != 0) {
            f32x4 mb[4]; float s = 0.f;
#pragma unroll
            for (int j = 0; j < 4; ++j) { mb[j] = *(const f32x4*)(MBp + (size_t)m * DM + 4 * lane + 256 * j); s += (mb[j].x * mb[j].x + mb[j].y * mb[j].y) + (mb[j].z * mb[j].z + mb[j].w * mb[j].w); }
            const float r = rsqrtf(wave_sum(s) * (1.f / DM) + EPS) * (MODE == 2 ? 1.0f : 0.5f);
#pragma unroll
            for (int j = 0; j < 4; ++j) { x[j] = x[j] + mb[j] * r * wq[j]; *(f32x4*)(Y + (size_t)m * DM + 4 * lane + 256 * j) = x[j]; }
        }
        if (MODE != 3) {
            float s = 0.f;
#pragma unroll
            for (int j = 0; j < 4; ++j) s += (x[j].x * x[j].x + x[j].y * x[j].y) + (x[j].z * x[j].z + x[j].w * x[j].w);
            const float r = rsqrtf(wave_sum(s) * (1.f / DM) + EPS);
            f32x4 h[4];
#pragma unroll
            for (int j = 0; j < 4; ++j) { h[j] = x[j] * r * wp[j];
                v2u o; o.x = pk2(h[j].x, h[j].y); o.y = pk2(h[j].z, h[j].w); *(v2u*)(XN + (size_t)m * DM + 4 * lane + 256 * j) = o; }
            if (MODE == 1) {
                float d[8];
#pragma unroll
                for (int c = 0; c < 8; ++c) d[c] = 0.f;
#pragma unroll
                for (int j = 0; j < 4; ++j)
#pragma unroll
                    for (int e = 0; e < 4; ++e) { const int k = 4 * lane + 256 * j + e; const f32x4 w0 = *(const LAS f32x4*)(wab + k * 8), w1 = *(const LAS f32x4*)(wab + k * 8 + 4); const float hv = h[j][e];
                        d[0] += hv * w0.x; d[1] += hv * w0.y; d[2] += hv * w0.z; d[3] += hv * w0.w; d[4] += hv * w1.x; d[5] += hv * w1.y; d[6] += hv * w1.z; d[7] += hv * w1.w; }
#pragma unroll
                for (int c = 0; c < 8; ++c) d[c] = wave_sum(d[c]);
                float mine = d[0];
#pragma unroll
                for (int c = 1; c < 8; ++c) mine = (lane == c) ? d[c] : mine;
                if (lane < 8) { float v;
                    if (lane < 4) { const float a = mine + dtb; const float sp = fmaxf(a, 0.f) + log1pf(__expf(-fabsf(a))); v = -alog * sp; }
                    else v = sigmf(mine);
                    ((float*)(F.ws + WS_GB))[(size_t)m * 8 + lane] = v; }
            }
        }
    }
}

template <bool SAMPLE> __device__ __forceinline__ void attn_unit(const Frame& F, const float* cache_k, const float* cache_v, const float* sinks, int b, int kvh, int qb) {
    constexpr int NK = SAMPLE ? 160 : 192, NT = NK / 16, NKS = NK / 32;
    LAS bf16* Ks = (LAS bf16*)(F.lds); LAS bf16* Vt = (LAS bf16*)(F.lds + 27648); LAS bf16* Pw = (LAS bf16*)(F.lds + 53248 + F.wave * 6400);
    const bf16* ZA = (const bf16*)(F.ws + WS_RA + RA_ZA); bf16* OA = (bf16*)(F.ws + WS_RC);
    const int kstart = SAMPLE ? 0 : qb * 64 - 128;
    for (int p = F.tid; p < NK * 8; p += 512) {
        const int kk = p >> 3, part = p & 7;
        v4u kv = {0u, 0u, 0u, 0u}, vv = {0u, 0u, 0u, 0u};
        if (SAMPLE) {
            if (kk < 128) { const size_t o = (((size_t)b * 128 + kk) * 2 + kvh) * 64 + part * 8;
                const f32x4 k0 = *(const f32x4*)(cache_k + o), k1 = *(const f32x4*)(cache_k + o + 4), v0 = *(const f32x4*)(cache_v + o), v1 = *(const f32x4*)(cache_v + o + 4);
                kv.x = pk2(k0.x, k0.y); kv.y = pk2(k0.z, k0.w); kv.z = pk2(k1.x, k1.y); kv.w = pk2(k1.z, k1.w);
                vv.x = pk2(v0.x, v0.y); vv.y = pk2(v0.z, v0.w); vv.z = pk2(v1.x, v1.y); vv.w = pk2(v1.z, v1.w);
            } else if (kk < 136) { const size_t row = (size_t)MP + b * 8 + (kk - 128);
                kv = *(const v4u*)(ZA + row * 768 + 512 + kvh * 64 + part * 8); vv = *(const v4u*)(ZA + row * 768 + 640 + kvh * 64 + part * 8); }
        } else {
            const int tok = kstart + kk;
            if (tok >= 0) { const size_t row = (size_t)b * SEQ + tok;
                kv = *(const v4u*)(ZA + row * 768 + 512 + kvh * 64 + part * 8); vv = *(const v4u*)(ZA + row * 768 + 640 + kvh * 64 + part * 8); }
        }
        *(LAS v4u*)(Ks + kk * 72 + part * 8) = kv;
        const unsigned vw[4] = {vv.x, vv.y, vv.z, vv.w};
#pragma unroll
        for (int i = 0; i < 4; ++i) { Vt[(part * 8 + 2 * i) * 200 + kk] = (bf16)(vw[i] & 0xffffu); Vt[(part * 8 + 2 * i + 1) * 200 + kk] = (bf16)(vw[i] >> 16); }
    }
    __syncthreads();
    const int fr = F.lane & 15, fq = F.lane >> 4;
    if (F.wave < (SAMPLE ? 2 : 8)) {
#pragma unroll 1
        for (int mt = 0; mt < (SAMPLE ? 1 : 2); ++mt) {
            int qi, head; size_t row;
            if (SAMPLE) { const int r = 16 * F.wave + fr; head = kvh * 4 + (r >> 3); qi = r & 7; row = (size_t)MP + b * 8 + qi; }
            else { head = kvh * 4 + (F.wave >> 1); qi = 32 * (F.wave & 1) + 16 * mt + fr; row = (size_t)b * SEQ + qb * 64 + qi; }
            bf16x8 qf[2];
#pragma unroll
            for (int ks = 0; ks < 2; ++ks) qf[ks] = *(const bf16x8*)(ZA + row * 768 + head * 64 + 32 * ks + 8 * fq);
            f32x4 s[NT];
#pragma unroll
            for (int nt = 0; nt < NT; ++nt) { s[nt] = (f32x4){0.f, 0.f, 0.f, 0.f};
#pragma unroll
                for (int ks = 0; ks < 2; ++ks) { const bf16x8 kf = *(const LAS bf16x8*)(Ks + (16 * nt + fr) * 72 + 32 * ks + 8 * fq); s[nt] = MFMA16(kf, qf[ks], s[nt]); } }
            float mx = -1e30f;
#pragma unroll
            for (int nt = 0; nt < NT; ++nt)
#pragma unroll
                for (int j = 0; j < 4; ++j) { const int kk = 16 * nt + 4 * fq + j; const bool valid = (kk > qi) && (kk <= 128 + qi) && (SAMPLE || kstart + kk >= 0);
                    const float v = valid ? s[nt][j] * 0.125f : -1e30f; s[nt][j] = v; mx = fmaxf(mx, v); }
            mx = fmaxf(mx, __shfl_xor(mx, 16)); mx = fmaxf(mx, __shfl_xor(mx, 32));
            const float sink = sinks[head]; mx = fmaxf(mx, sink);
            float sum = 0.f;
#pragma unroll
            for (int nt = 0; nt < NT; ++nt) {
#pragma unroll
                for (int j = 0; j < 4; ++j) { const float p = __expf(s[nt][j] - mx); s[nt][j] = p; sum += p; }
                v2u w; w.x = pk2(s[nt][0], s[nt][1]); w.y = pk2(s[nt][2], s[nt][3]); *(LAS v2u*)(Pw + fr * 200 + 16 * nt + 4 * fq) = w; }
            sum += __shfl_xor(sum, 16); sum += __shfl_xor(sum, 32);
            const float inv = 1.0f / (sum + __expf(sink - mx));
            LDS_FENCE();
            f32x4 o[4];
#pragma unroll
            for (int nd = 0; nd < 4; ++nd) o[nd] = (f32x4){0.f, 0.f, 0.f, 0.f};
#pragma unroll
            for (int ks = 0; ks < NKS; ++ks) { const bf16x8 pf = *(const LAS bf16x8*)(Pw + fr * 200 + 32 * ks + 8 * fq);
#pragma unroll
                for (int nd = 0; nd < 4; ++nd) { const bf16x8 vf = *(const LAS bf16x8*)(Vt + (16 * nd + fr) * 200 + 32 * ks + 8 * fq); o[nd] = MFMA16(vf, pf, o[nd]); } }
#pragma unroll
            for (int nd = 0; nd < 4; ++nd) { v2u w; w.x = pk2(o[nd][0] * inv, o[nd][1] * inv); w.y = pk2(o[nd][2] * inv, o[nd][3] * inv);
                *(v2u*)(OA + row * 512 + head * 64 + 16 * nd + 4 * fq) = w; }
            LDS_FENCE();
        }
    }
    __syncthreads();
}

__device__ __forceinline__ void prep_pair(const Frame& F, const float* conv_w, int pair) {
    const int hb = F.tid >> 8, t = F.tid & 255, hw = F.wave & 3, lane = F.lane, fr = lane & 15, fq = lane >> 4;
    const int uid = 2 * pair + hb, b = uid >> 7, h = (uid >> 5) & 3, ch = uid & 31;
    LAS unsigned char* L = F.lds + hb * PREP_HALF;
    LAS bf16* Xq = (LAS bf16*)L; LAS bf16* Xk = Xq + 64 * 136; LAS bf16* Xv = Xk + 64 * 136;
    LAS float* Mf = (LAS float*)(L + 52224); LAS float* sc = (LAS float*)(L + 52224 + 16384);
    const bf16* ZC = (const bf16*)(F.ws + WS_RA + RA_ZC); const float* GB = (const float*)(F.ws + WS_GB);
    unsigned char* PU = F.ws + WS_RB + (size_t)uid * PREP_UNIT;
    const size_t row0 = (size_t)b * SEQ + ch * 64;
    if (hw == 0) {
        const float g = GB[(row0 + lane) * 8 + h], bt = GB[(row0 + lane) * 8 + 4 + h];
        float c = g;
#pragma unroll
        for (int o = 1; o < 64; o <<= 1) { const float n = __shfl_up(c, o); if (lane >= o) c += n; }
        sc[lane] = c; sc[64 + lane] = bt; sc[128 + lane] = __expf(c);
    }
    {
        const int c = t & 127, th = t >> 7;
#pragma unroll 1
        for (int grp = 0; grp < 3; ++grp) {
            const int chn = grp * 512 + h * 128 + c;
            const float w0 = conv_w[chn], w1 = conv_w[CONVD + chn], w2 = conv_w[2 * CONVD + chn], w3 = conv_w[3 * CONVD + chn];
            const int trel = ch * 64 + th * 32;
            const bf16* src = ZC + (row0 + th * 32) * CONVD + chn;
            float xm3 = trel >= 3 ? bf2f(src[-3 * CONVD]) : 0.f, xm2 = trel >= 2 ? bf2f(src[-2 * CONVD]) : 0.f, xm1 = trel >= 1 ? bf2f(src[-1 * CONVD]) : 0.f;
            LAS bf16* X = grp == 0 ? Xq : (grp == 1 ? Xk : Xv);
#pragma unroll 8
            for (int i = 0; i < 32; ++i) { const float x = bf2f(src[(size_t)i * CONVD]); const float o = w0 * xm3 + w1 * xm2 + w2 * xm1 + w3 * x;
                X[(th * 32 + i) * 136 + c] = (bf16)f2bf(siluf(o)); xm3 = xm2; xm2 = xm1; xm1 = x; }
        }
    }
    __syncthreads();
    if (t < 128) { const int grp = t >> 6, i = t & 63; const LAS bf16* X = (grp == 0 ? Xq : Xk) + i * 136; float ss = 0.f;
#pragma unroll
        for (int k = 0; k < 16; ++k) { const v4u w = *(const LAS v4u*)(X + 8 * k); const float a0 = blo(w.x), a1 = bhi(w.x), a2 = blo(w.y), a3 = bhi(w.y), a4 = blo(w.z), a5 = bhi(w.z), a6 = blo(w.w), a7 = bhi(w.w);
            ss += (a0 * a0 + a1 * a1) + (a2 * a2 + a3 * a3) + (a4 * a4 + a5 * a5) + (a6 * a6 + a7 * a7); }
        sc[192 + grp * 64 + i] = rsqrtf(ss + EPS); }
    __syncthreads();
    {
        const int i = 16 * hw + fr;
        f32x4 kk[4], qk[4];
#pragma unroll
        for (int nt = 0; nt < 4; ++nt) { kk[nt] = (f32x4){0.f, 0.f, 0.f, 0.f}; qk[nt] = (f32x4){0.f, 0.f, 0.f, 0.f}; }
#pragma unroll
        for (int ks = 0; ks < 4; ++ks) { const bf16x8 ak = *(const LAS bf16x8*)(Xk + i * 136 + 32 * ks + 8 * fq), aq = *(const LAS bf16x8*)(Xq + i * 136 + 32 * ks + 8 * fq);
#pragma unroll
            for (int nt = 0; nt < 4; ++nt) { const bf16x8 bk = *(const LAS bf16x8*)(Xk + (16 * nt + fr) * 136 + 32 * ks + 8 * fq); kk[nt] = MFMA16(bk, ak, kk[nt]); qk[nt] = MFMA16(bk, aq, qk[nt]); } }
        const float gi = sc[i], bi = sc[64 + i], rki = sc[256 + i], rqi = sc[192 + i] * 0.08838834764831845f;
        bf16* QKg = (bf16*)(PU + PU_QK);
#pragma unroll
        for (int nt = 0; nt < 4; ++nt) { f32x4 mv, qv;
#pragma unroll
            for (int jj = 0; jj < 4; ++jj) { const int j = 16 * nt + 4 * fq + jj; const float gj = sc[j], rkj = sc[256 + j];
                const float dec = (i >= j) ? __expf(gi - gj) : 0.f;
                mv[jj] = (i > j) ? kk[nt][jj] * rki * rkj * bi * dec : 0.f; qv[jj] = (i >= j) ? qk[nt][jj] * rqi * rkj * dec : 0.f; }
            *(LAS f32x4*)(Mf + i * 64 + 16 * nt + 4 * fq) = mv;
            v2u w; w.x = pk2(qv[0], qv[1]); w.y = pk2(qv[2], qv[3]); *(v2u*)(QKg + i * 64 + 16 * nt + 4 * fq) = w; }
    }
    __syncthreads();
    {
        float x[64];
        if (t < 128) {
#pragma unroll
            for (int i = 0; i < 64; ++i) x[i] = bf2f(Xk[i * 136 + t]) * (sc[256 + i] * sc[64 + i] * sc[128 + i]);
        } else {
#pragma unroll
            for (int i = 0; i < 64; ++i) x[i] = bf2f(Xv[i * 136 + (t - 128)]) * sc[64 + i];
        }
#pragma unroll
        for (int i = 1; i < 64; ++i) { float a = x[i];
#pragma unroll
            for (int j = 0; j < i; ++j) a -= Mf[i * 64 + j] * x[j];
            x[i] = a; }
        if (t < 128) { bf16* KC = (bf16*)(PU + PU_KC);
#pragma unroll
            for (int i = 0; i < 64; ++i) KC[i * 128 + t] = (bf16)f2bf(x[i]);
        } else { bf16* VU = (bf16*)(PU + PU_VU) + (t - 128) * 64;
#pragma unroll
            for (int k = 0; k < 8; ++k) { v4u w; w.x = pk2(x[8 * k], x[8 * k + 1]); w.y = pk2(x[8 * k + 2], x[8 * k + 3]); w.z = pk2(x[8 * k + 4], x[8 * k + 5]); w.w = pk2(x[8 * k + 6], x[8 * k + 7]); *(v4u*)(VU + 8 * k) = w; }
        }
    }
    {
        const int i = t >> 2, d0 = (t & 3) * 32; const float sq = sc[192 + i] * 0.08838834764831845f * sc[128 + i];
        bf16* QD = (bf16*)(PU + PU_QD) + i * 128 + d0;
#pragma unroll
        for (int k = 0; k < 4; ++k) { const v4u w = *(const LAS v4u*)(Xq + i * 136 + d0 + 8 * k); v4u o;
            o.x = pk2(blo(w.x) * sq, bhi(w.x) * sq); o.y = pk2(blo(w.y) * sq, bhi(w.y) * sq); o.z = pk2(blo(w.z) * sq, bhi(w.z) * sq); o.w = pk2(blo(w.w) * sq, bhi(w.w) * sq); *(v4u*)(QD + 8 * k) = o; }
        const int d = t >> 1, c0 = (t & 1) * 32; const float gl = sc[63];
        bf16* KD = (bf16*)(PU + PU_KD) + d * 64 + c0;
#pragma unroll
        for (int k = 0; k < 4; ++k) { float v[8];
#pragma unroll
            for (int e = 0; e < 8; ++e) { const int c = c0 + 8 * k + e; v[e] = bf2f(Xk[c * 136 + d]) * sc[256 + c] * __expf(gl - sc[c]); }
            v4u o; o.x = pk2(v[0], v[1]); o.y = pk2(v[2], v[3]); o.z = pk2(v[4], v[5]); o.w = pk2(v[6], v[7]); *(v4u*)(KD + 8 * k) = o; }
        if (t == 0) ((float*)(F.ws + WS_GT))[uid] = sc[128 + 63];
    }
    __syncthreads();
}

__device__ __forceinline__ void scan_unit(const Frame& F, int unit) {
    const int bh = unit >> 3, es = unit & 7, b = bh >> 2, h = bh & 3, w = F.wave, lane = F.lane, fr = lane & 15, fq = lane >> 4;
    LAS bf16* Ss = (LAS bf16*)F.lds; LAS bf16* Vn = (LAS bf16*)(F.lds + 4352);
    for (int p = F.tid; p < (4352 + 2304) / 4; p += 512) ((LAS unsigned*)F.lds)[p] = 0u;
    float* OBR = (float*)(F.ws + WS_RA + RA_ZC);
    f32x4 S = {0.f, 0.f, 0.f, 0.f};
    __syncthreads();
#pragma unroll 1
    for (int n = 0; n < 32; ++n) {
        const unsigned char* PU = F.ws + WS_RB + (size_t)(bh * 32 + n) * PREP_UNIT;
        const float gt = ((const float*)(F.ws + WS_GT))[bh * 32 + n];
        bf16x8 kd[2];
#pragma unroll
        for (int ks = 0; ks < 2; ++ks) kd[ks] = *(const bf16x8*)((const bf16*)(PU + PU_KD) + (16 * w + fr) * 64 + 32 * ks + 8 * fq);
        f32x4 O = {0.f, 0.f, 0.f, 0.f};
        bf16x8 qkf[2];
        if (w < 4) {
            bf16x8 kc[4], qd[4];
#pragma unroll
            for (int ks = 0; ks < 4; ++ks) { kc[ks] = *(const bf16x8*)((const bf16*)(PU + PU_KC) + (16 * w + fr) * 128 + 32 * ks + 8 * fq); qd[ks] = *(const bf16x8*)((const bf16*)(PU + PU_QD) + (16 * w + fr) * 128 + 32 * ks + 8 * fq); }
#pragma unroll
            for (int ks = 0; ks < 2; ++ks) qkf[ks] = *(const bf16x8*)((const bf16*)(PU + PU_QK) + (16 * w + fr) * 64 + 32 * ks + 8 * fq);
            const v2u vu = *(const v2u*)((const bf16*)(PU + PU_VU) + (16 * es + fr) * 64 + 16 * w + 4 * fq);
            f32x4 X = {0.f, 0.f, 0.f, 0.f};
#pragma unroll
            for (int ks = 0; ks < 4; ++ks) { const bf16x8 sf = *(const LAS bf16x8*)(Ss + fr * 136 + 32 * ks + 8 * fq); X = MFMA16(kc[ks], sf, X); O = MFMA16(qd[ks], sf, O); }
            v2u o; o.x = pk2(blo(vu.x) - X[0], bhi(vu.x) - X[1]); o.y = pk2(blo(vu.y) - X[2], bhi(vu.y) - X[3]);
            *(LAS v2u*)(Vn + fr * 72 + 16 * w + 4 * fq) = o;
        }
        __syncthreads();
        bf16x8 vf[2];
#pragma unroll
        for (int ks = 0; ks < 2; ++ks) vf[ks] = *(const LAS bf16x8*)(Vn + fr * 72 + 32 * ks + 8 * fq);
        if (w < 4) {
#pragma unroll
            for (int ks = 0; ks < 2; ++ks) O = MFMA16(qkf[ks], vf[ks], O);
            const size_t row = (size_t)b * SEQ + 64 * n + 16 * w + 4 * fq;
#pragma unroll
            for (int j = 0; j < 4; ++j) OBR[(row + j) * 512 + h * 128 + 16 * es + fr] = O[j];
        }
        S = S * gt;
#pragma unroll
        for (int ks = 0; ks < 2; ++ks) S = MFMA16(kd[ks], vf[ks], S);
        { v2u o; o.x = pk2(S[0], S[1]); o.y = pk2(S[2], S[3]); *(LAS v2u*)(Ss + fr * 136 + 16 * w + 4 * fq) = o; }
        __syncthreads();
    }
    float* DP = F.out + O_DP + (size_t)bh * 128 * 128;
#pragma unroll
    for (int j = 0; j < 4; ++j) DP[(16 * w + 4 * fq + j) * 128 + 16 * es + fr] = S[j];
    __syncthreads();
}

__device__ __forceinline__ void dn_sample_unit(const Frame& F, const float* state_conv, const float* state_delta, const float* conv_w, const float* out_norm, int unit) {
    const int b = unit >> 2, h = unit & 3, tid = F.tid, e = tid & 127, dq = tid >> 7, lane = F.lane, w = F.wave;
    LAS float* X = (LAS float*)F.lds;
    LAS float* scl = (LAS float*)(F.lds + 12288);
    LAS float* pA = (LAS float*)(F.lds + 12544);
    LAS float* pB = (LAS float*)(F.lds + 14592);
    LAS float* osm = (LAS float*)(F.lds + 16640);
    const bf16* ZC = (const bf16*)(F.ws + WS_RA + RA_ZC); const bf16* ZZ = (const bf16*)(F.ws + WS_RA + RA_ZZ); const float* GB = (const float*)(F.ws + WS_GB);
    bf16* OB = (bf16*)(F.ws + WS_RC) + (size_t)MROWS * 512;
    const size_t row0 = (size_t)MP + b * 8;
#pragma unroll 1
    for (int r = 0; r < 6; ++r) { const int idx = tid + 512 * r, grp = idx >> 10, i = (idx >> 7) & 7, c = idx & 127, chn = grp * 512 + h * 128 + c;
        float acc = 0.f;
#pragma unroll
        for (int j = 0; j < 4; ++j) { const int tt = i - 3 + j; const float xv = tt < 0 ? state_conv[((size_t)b * 3 + (3 + tt)) * CONVD + chn] : bf2f(ZC[(row0 + tt) * CONVD + chn]); acc += conv_w[j * CONVD + chn] * xv; }
        X[idx] = siluf(acc); }
    if (tid < 8) { scl[16 + tid] = GB[(row0 + tid) * 8 + h]; scl[24 + tid] = GB[(row0 + tid) * 8 + 4 + h]; }
    __syncthreads();
    { const float q0 = X[w * 128 + lane], q1 = X[w * 128 + lane + 64], k0 = X[1024 + w * 128 + lane], k1 = X[1024 + w * 128 + lane + 64];
      const float sq = wave_sum(q0 * q0 + q1 * q1), sk = wave_sum(k0 * k0 + k1 * k1);
      if (lane == 0) { scl[w] = rsqrtf(sq + EPS) * 0.08838834764831845f; scl[8 + w] = rsqrtf(sk + EPS); } }
    float s[32];
    const float* S0 = state_delta + ((size_t)unit * 128 + 32 * dq) * 128 + e;
#pragma unroll
    for (int r = 0; r < 32; ++r) s[r] = S0[(size_t)r * 128];
    __syncthreads();
#pragma unroll 1
    for (int i = 0; i < 8; ++i) {
        const float eg = __expf(scl[16 + i]), bt = scl[24 + i], rk = scl[8 + i], rq = scl[i];
        const LAS float* kr = X + 1024 + i * 128 + 32 * dq; const LAS float* qr = X + i * 128 + 32 * dq;
        float p = 0.f;
#pragma unroll
        for (int r = 0; r < 32; ++r) { s[r] *= eg; p += kr[r] * s[r]; }
        pA[dq * 128 + e] = p * rk;
        __syncthreads();
        const float kS = (pA[e] + pA[128 + e]) + (pA[256 + e] + pA[384 + e]);
        const float u = bt * (X[2048 + i * 128 + e] - kS) * rk;
        float p2 = 0.f;
#pragma unroll
        for (int r = 0; r < 32; ++r) { s[r] += kr[r] * u; p2 += qr[r] * s[r]; }
        pB[dq * 128 + e] = p2 * rq;
        __syncthreads();
        if (dq == 0) osm[i * 128 + e] = (pB[e] + pB[128 + e]) + (pB[256 + e] + pB[384 + e]);
    }
    __syncthreads();
    {
        const float o0 = osm[w * 128 + lane], o1 = osm[w * 128 + lane + 64];
        const float r = rsqrtf(wave_sum(o0 * o0 + o1 * o1) * (1.f / 128.f) + EPS);
        const size_t row = row0 + w;
        const float z0 = bf2f(ZZ[row * 512 + h * 128 + lane]), z1 = bf2f(ZZ[row * 512 + h * 128 + lane + 64]);
        OB[row * 512 + h * 128 + lane] = (bf16)f2bf(o0 * r * out_norm[lane] * siluf(z0));
        OB[row * 512 + h * 128 + lane + 64] = (bf16)f2bf(o1 * r * out_norm[lane + 64] * siluf(z1));
    }
    float* DSo = F.out + O_DS + ((size_t)unit * 128 + 32 * dq) * 128 + e;
#pragma unroll
    for (int r = 0; r < 32; ++r) DSo[(size_t)r * 128] = s[r];
    __syncthreads();
}

#ifdef DIAG_DN
__device__ __forceinline__ void dn_prompt_slow(const Frame& F, const float* conv_w, const float* out_norm, int unit) {
    const int b = unit >> 2, h = unit & 3, tid = F.tid, e = tid & 127, dq = tid >> 7, lane = F.lane, w = F.wave;
    LAS float* X = (LAS float*)F.lds; LAS float* scl = (LAS float*)(F.lds + 12288); LAS float* pA = (LAS float*)(F.lds + 12544); LAS float* pB = (LAS float*)(F.lds + 14592); LAS float* osm = (LAS float*)(F.lds + 16640);
    const bf16* ZC = (const bf16*)(F.ws + WS_RA + RA_ZC); const bf16* ZZ = (const bf16*)(F.ws + WS_RA + RA_ZZ); const float* GB = (const float*)(F.ws + WS_GB);
    bf16* OB = (bf16*)(F.ws + WS_RC) + (size_t)MROWS * 512;
    float s[32];
#pragma unroll
    for (int r = 0; r < 32; ++r) s[r] = 0.f;
#pragma unroll 1
    for (int g8 = 0; g8 < SEQ / 8; ++g8) {
        const size_t row0 = (size_t)b * SEQ + g8 * 8;
#pragma unroll 1
        for (int r = 0; r < 6; ++r) { const int idx = tid + 512 * r, grp = idx >> 10, i = (idx >> 7) & 7, c = idx & 127, chn = grp * 512 + h * 128 + c;
            float acc = 0.f;
#pragma unroll
            for (int j = 0; j < 4; ++j) { const int tt = i - 3 + j; const float xv = (g8 * 8 + tt < 0) ? 0.f : bf2f(ZC[(row0 + tt) * CONVD + chn]); acc += conv_w[j * CONVD + chn] * xv; }
            X[idx] = siluf(acc); }
        if (tid < 8) { scl[16 + tid] = GB[(row0 + tid) * 8 + h]; scl[24 + tid] = GB[(row0 + tid) * 8 + 4 + h]; }
        __syncthreads();
        { const float q0 = X[w * 128 + lane], q1 = X[w * 128 + lane + 64], k0 = X[1024 + w * 128 + lane], k1 = X[1024 + w * 128 + lane + 64];
          const float sq = wave_sum(q0 * q0 + q1 * q1), sk = wave_sum(k0 * k0 + k1 * k1);
          if (lane == 0) { scl[w] = rsqrtf(sq + EPS) * 0.08838834764831845f; scl[8 + w] = rsqrtf(sk + EPS); } }
        __syncthreads();
#pragma unroll 1
        for (int i = 0; i < 8; ++i) {
            const float eg = __expf(scl[16 + i]), bt = scl[24 + i], rk = scl[8 + i], rq = scl[i];
            const LAS float* kr = X + 1024 + i * 128 + 32 * dq; const LAS float* qr = X + i * 128 + 32 * dq;
            float p = 0.f;
#pragma unroll
            for (int r = 0; r < 32; ++r) { s[r] *= eg; p += kr[r] * s[r]; }
            pA[dq * 128 + e] = p * rk;
            __syncthreads();
            const float kS = (pA[e] + pA[128 + e]) + (pA[256 + e] + pA[384 + e]);
            const float u = bt * (X[2048 + i * 128 + e] - kS) * rk;
            float p2 = 0.f;
#pragma unroll
            for (int r = 0; r < 32; ++r) { s[r] += kr[r] * u; p2 += qr[r] * s[r]; }
            pB[dq * 128 + e] = p2 * rq;
            __syncthreads();
            if (dq == 0) osm[i * 128 + e] = (pB[e] + pB[128 + e]) + (pB[256 + e] + pB[384 + e]);
        }
        __syncthreads();
        {   const float o0 = osm[w * 128 + lane], o1 = osm[w * 128 + lane + 64];
            const float r = rsqrtf(wave_sum(o0 * o0 + o1 * o1) * (1.f / 128.f) + EPS);
            const size_t row = row0 + w;
            const float z0 = bf2f(ZZ[row * 512 + h * 128 + lane]), z1 = bf2f(ZZ[row * 512 + h * 128 + lane + 64]);
            OB[row * 512 + h * 128 + lane] = (bf16)f2bf(o0 * r * out_norm[lane] * siluf(z0));
            OB[row * 512 + h * 128 + lane + 64] = (bf16)f2bf(o1 * r * out_norm[lane + 64] * siluf(z1));
        }
        __syncthreads();
    }
    float* DSo = F.out + O_DP + ((size_t)unit * 128 + 32 * dq) * 128 + e;
#pragma unroll
    for (int r = 0; r < 32; ++r) DSo[(size_t)r * 128] = s[r];
    __syncthreads();
}
#endif

__device__ __forceinline__ void gated_norm_prompt(const Frame& F, const float* out_norm) {
    const int gw = F.vcu * NWAVES + F.wave, NGW = F.G * NWAVES, lane = F.lane, head = lane >> 4, e0 = (lane & 15) * 8;
    const float* OBR = (const float*)(F.ws + WS_RA + RA_ZC); const bf16* ZZ = (const bf16*)(F.ws + WS_RA + RA_ZZ); bf16* OB = (bf16*)(F.ws + WS_RC) + (size_t)MROWS * 512;
    const f32x4 w0 = *(const f32x4*)(out_norm + e0), w1 = *(const f32x4*)(out_norm + e0 + 4);
    for (int m = gw; m < MP; m += NGW) {
        const size_t o = (size_t)m * 512 + head * 128 + e0;
        const f32x4 a = *(const f32x4*)(OBR + o), c = *(const f32x4*)(OBR + o + 4); const v4u z = *(const v4u*)(ZZ + o);
        float ss = (a.x * a.x + a.y * a.y) + (a.z * a.z + a.w * a.w) + (c.x * c.x + c.y * c.y) + (c.z * c.z + c.w * c.w);
        ss += __shfl_xor(ss, 1); ss += __shfl_xor(ss, 2); ss += __shfl_xor(ss, 4); ss += __shfl_xor(ss, 8);
        const float r = rsqrtf(ss * (1.f / 128.f) + EPS);
        v4u ov; ov.x = pk2(a.x * r * w0.x * siluf(blo(z.x)), a.y * r * w0.y * siluf(bhi(z.x))); ov.y = pk2(a.z * r * w0.z * siluf(blo(z.y)), a.w * r * w0.w * siluf(bhi(z.y)));
        ov.z = pk2(c.x * r * w1.x * siluf(blo(z.z)), c.y * r * w1.y * siluf(bhi(z.z))); ov.w = pk2(c.z * r * w1.z * siluf(blo(z.w)), c.w * r * w1.w * siluf(bhi(z.w)));
        *(v4u*)(OB + o) = ov;
    }
}

__device__ __forceinline__ void copy_outputs(const Frame& F, const float* cache_k, const float* cache_v) {
    const bf16* ZA = (const bf16*)(F.ws + WS_RA + RA_ZA); const bf16* ZC = (const bf16*)(F.ws + WS_RA + RA_ZC);
    const size_t gt = (size_t)F.vcu * 512 + F.tid, GS = (size_t)F.G * 512;
    for (size_t idx = gt; idx < 2 * 131072; idx += GS) { const int which = (int)(idx >> 17), rem = (int)(idx & 131071), br = rem >> 7, c = rem & 127, b = br >> 7, r = br & 127;
        F.out[O_KP + idx] = bf2f(ZA[((size_t)b * SEQ + 1920 + r) * 768 + 512 + which * 128 + c]); }
    for (size_t idx = gt; idx < 2 * 2097152; idx += GS) { const int which = (int)(idx >> 21), rem = (int)(idx & 2097151), br = rem >> 7, c = rem & 127, b = br >> 7, r = br & 127;
        float v; if (r < 120) v = (which ? cache_v : cache_k)[((size_t)b * 128 + r + 8) * 128 + c]; else v = bf2f(ZA[((size_t)MP + b * 8 + (r - 120)) * 768 + 512 + which * 128 + c]);
        F.out[O_KS + idx] = v; }
    for (size_t idx = gt; idx < 36864; idx += GS) { const int b = (int)(idx / 4608), j = (int)(idx % 4608) / CONVD, c = (int)(idx % CONVD);
        F.out[O_CP + idx] = bf2f(ZC[((size_t)b * SEQ + 2045 + j) * CONVD + c]); }
    for (size_t idx = gt; idx < 589824; idx += GS) { const int b = (int)(idx / 4608), j = (int)(idx % 4608) / CONVD, c = (int)(idx % CONVD);
        F.out[O_CS + idx] = bf2f(ZC[((size_t)MP + b * 8 + 5 + j) * CONVD + c]); }
}

#ifdef DIAG_CHK
__device__ __forceinline__ void chk_put(const Frame& F, int stage, float got, float ref) {
    const float err = fabsf(got - ref) / (fabsf(ref) + 0.05f);
    if (F.lane == 0) atomicMax((unsigned*)(F.ws + WS_CTL + 32768) + stage, __float_as_uint(err));
}
__device__ __forceinline__ float dotbw(const bf16* a, const float* W, int K, int ldw, int col, int lane) {
    float s = 0.f;
    for (int k = lane; k < K; k += 64) s += bf2f(a[k]) * bf2f((bf16)f2bf(W[(size_t)k * ldw + col]));
    return wave_sum(s);
}
__device__ __forceinline__ int chk_row(int si) { return (int)(((unsigned)si * 1361u + 5u) % (unsigned)MROWS); }
__device__ __forceinline__ int chk_col(int si, int N) { return (int)(((unsigned)si * 977u + 13u) % (unsigned)N); }
#define CHK_LOOP for (int si = F.wave; si < 64; si += 8)
#endif

struct Args { const float* in[25]; float* out; unsigned char* ws; };
__global__ void __launch_bounds__(NWAVES * 64, 2) mega_fwd(Args args) {
    extern __shared__ __attribute__((aligned(16))) unsigned char lds_raw[];
    Frame F;
    F.lds = (LAS unsigned char*)lds_raw;
    F.tid = threadIdx.x; F.lane = F.tid & 63; F.wave = __builtin_amdgcn_readfirstlane(F.tid >> 6);
    F.G = gridDim.x; { const int bx = blockIdx.x; F.vcu = (F.G % 8 == 0) ? (bx % 8) * (F.G / 8) + bx / 8 : bx; }
    F.out = args.out; F.ws = args.ws;
    volatile LAS unsigned* MISC = (volatile LAS unsigned*)(F.lds + MISC_OFF);
    if (F.tid < 64) MISC[F.tid] = 0u;
    __syncthreads();
    XcdBarrier bar = xcd_barrier_post((unsigned*)(F.ws + WS_CTL) + CW_BAR, MISC + 8);
#ifdef DIAG_FLUSH
#define L2_FLUSH() do { const f32x4* p_ = (const f32x4*)args.in[0] + (size_t)blockIdx.x * 16384; f32x4 a_ = {0.f, 0.f, 0.f, 0.f}; for (int i_ = F.tid; i_ < 16384; i_ += 512) a_ += p_[i_]; \
    asm volatile("" :: "v"(a_.x + a_.y + a_.z + a_.w)); asm volatile("s_waitcnt vmcnt(0)" ::: "memory"); __syncthreads(); } while (0)
#else
#define L2_FLUSH() do {} while (0)
#endif
#define GRID_BAR() do { xcd_barrier(bar); int t_ = threadIdx.x; asm volatile("" : "+v"(t_)); F.tid = t_; F.lane = t_ & 63; L2_FLUSH(); } while (0)
    bf16* wb = (bf16*)(F.ws + WS_W); bf16* XN = (bf16*)(F.ws + WS_XN);
    bf16* ACT = (bf16*)(F.ws + WS_RA); bf16* ZA = (bf16*)(F.ws + WS_RA + RA_ZA); bf16* ZC = (bf16*)(F.ws + WS_RA + RA_ZC); bf16* ZZ = (bf16*)(F.ws + WS_RA + RA_ZZ);
    float* MB = (float*)(F.ws + WS_RB); bf16* SG = (bf16*)(F.ws + WS_RB);
    bf16* OA = (bf16*)(F.ws + WS_RC); bf16* OB = OA + (size_t)MROWS * 512;
    const int cu = (int)blockIdx.x;

    convert_ffn_weights(F, args.in[8], args.in[9], 0);
    { const size_t gt = (size_t)F.vcu * 512 + F.tid; for (size_t i = gt; i < 8192; i += (size_t)F.G * 512) ((float*)(F.ws + WS_WAB))[i] = args.in[12][(i >> 3) * INDIM + 2816 + (i & 7)]; }
    rowwise<0>(F, nullptr, args.in[6], args.in[0], args.in[1], nullptr, nullptr);
    GRID_BAR();
    { pg8::Gemm g{XN, XN, wb + W_UP / 2, wb + W_UP / 2, DM, DM / 64}; pg8::StaticOrder S; S.init(MROWS, NUP, F.G, cu); pg8::EpiSwiglu E{ACT, FF};
      pg8::gemm_phase<pg8::EpiSwiglu, pg8::StaticOrder, true, true>(F.lds, g, S, E); }
    GRID_BAR();
#ifdef DIAG_CHK
    if (CHKSET == 1 && F.vcu == 0) { CHK_LOOP { const int r = chk_row(si), j = chk_col(si, FF); const bf16* a = XN + (size_t)r * DM;
        const float g = dotbw(a, args.in[8], DM, NUP, j, F.lane), u = dotbw(a, args.in[8], DM, NUP, FF + j, F.lane);
        chk_put(F, 1, bf2f(ACT[(size_t)r * FF + j]), siluf(g) * u); } }
    GRID_BAR();
#endif
    { pg8::Gemm g{ACT, ACT, wb + W_DOWN / 2, wb + W_DOWN / 2, FF, FF / 64}; pg8::StaticOrder S; S.init(MROWS, DM, F.G, cu); pg8::EpiF32 E{MB, DM};
      pg8::gemm_phase<pg8::EpiF32, pg8::StaticOrder, true, true>(F.lds, g, S, E); }
    GRID_BAR();
#ifdef DIAG_CHK
    if (CHKSET == 1 && F.vcu == 0) { CHK_LOOP { const int r = chk_row(si), c = chk_col(si, DM);
        chk_put(F, 2, MB[(size_t)r * DM + c], dotbw(ACT + (size_t)r * FF, args.in[9], FF, DM, c, F.lane)); } }
    GRID_BAR();
#endif
    { const float* wab = (const float*)(F.ws + WS_WAB); for (int i = F.tid; i < 8192; i += 512) ((LAS float*)F.lds)[i] = wab[i]; }
    convert_mix_weights(F, args.in[12], args.in[18], args.in[19], args.in[20], 32768);
    __syncthreads();
    rowwise<1>(F, args.in[7], args.in[10], args.in[0], args.in[1], args.in[15], args.in[16]);
    GRID_BAR();
#ifdef DIAG_CHK
    if (CHKSET == 1 && F.vcu == 0) { CHK_LOOP { const int r = chk_row(si), c = chk_col(si, DM); const float* xr = (r < MP) ? args.in[0] + (size_t)r * DM : args.in[1] + (size_t)(r - MP) * DM;
        float sm = 0.f, sy = 0.f; for (int k = F.lane; k < DM; k += 64) { const float mv = MB[(size_t)r * DM + k], yv = F.out[(size_t)r * DM + k]; sm += mv * mv; sy += yv * yv; }
        sm = wave_sum(sm); sy = wave_sum(sy);
        const float x1 = xr[c] + 0.5f * MB[(size_t)r * DM + c] * rsqrtf(sm / DM + EPS) * args.in[7][c];
        chk_put(F, 3, F.out[(size_t)r * DM + c], x1);
        chk_put(F, 3, bf2f(XN[(size_t)r * DM + c]), F.out[(size_t)r * DM + c] * rsqrtf(sy / DM + EPS) * args.in[10][c]); } }
    GRID_BAR();
#endif
    { pg8::Gemm g{XN, XN, wb + W_IN1 / 2, wb + W_IN1 / 2, DM, DM / 64}; pg8::StaticOrder S; S.init(MROWS, NZ1, F.G, cu); pg8::EpiBf16Z<0> E{ZA, ZC, ZZ, 768, 1536, 512, 3, 9};
      pg8::gemm_phase<pg8::EpiBf16Z<0>, pg8::StaticOrder, true, true>(F.lds, g, S, E); }
    GRID_BAR();
#ifdef DIAG_CHK
    if (CHKSET == 1 && F.vcu == 0) { CHK_LOOP { const int r = chk_row(si), c = chk_col(si, NZ1);
        const float got = c < 768 ? bf2f(ZA[(size_t)r * 768 + c]) : (c < 2304 ? bf2f(ZC[(size_t)r * 1536 + c - 768]) : bf2f(ZZ[(size_t)r * 512 + c - 2304]));
        chk_put(F, 4, got, dotbw(XN + (size_t)r * DM, args.in[12], DM, INDIM, c, F.lane)); } }
    if (CHKSET == 1 && F.vcu == 1) { CHK_LOOP { const int c = chk_col(si, NGATE), k = chk_col(si * 3 + 1, DM);
        chk_put(F, 9, bf2f(wb[W_G / 2 + (size_t)c * DM + k]), bf2f((bf16)f2bf(args.in[12][(size_t)k * INDIM + 2824 + c])));
        const int c2 = chk_col(si, DM), k2 = chk_col(si * 5 + 2, 512);
        chk_put(F, 10, bf2f(wb[W_A / 2 + (size_t)c2 * 512 + k2]), bf2f((bf16)f2bf(args.in[18][(size_t)k2 * DM + c2])));
        chk_put(F, 10, bf2f(wb[W_B / 2 + (size_t)c2 * 512 + k2]), bf2f((bf16)f2bf(args.in[19][(size_t)k2 * DM + c2])));
        chk_put(F, 10, bf2f(wb[W_O / 2 + (size_t)c2 * DM + k]), bf2f((bf16)f2bf(args.in[20][(size_t)k * DM + c2]))); } }
    GRID_BAR();
#endif
    for (int u = F.vcu; u < 512; u += F.G) attn_unit<false>(F, nullptr, nullptr, args.in[13], u >> 6, (u >> 5) & 1, u & 31);
    for (int u = F.vcu; u < 256; u += F.G) attn_unit<true>(F, args.in[2], args.in[3], args.in[13], u >> 1, u & 1, 0);
#ifdef DIAG_DN
    for (int u = F.vcu; u < 32; u += F.G) dn_prompt_slow(F, args.in[14], args.in[17], u);
#else
    for (int u = F.vcu; u < 512; u += F.G) prep_pair(F, args.in[14], u);
#endif
    for (int u = F.vcu; u < 512; u += F.G) dn_sample_unit(F, args.in[4], args.in[5], args.in[14], args.in[17], u);
    copy_outputs(F, args.in[2], args.in[3]);
    GRID_BAR();
#ifdef DIAG_CHK
    if (CHKSET == 1 && F.vcu == 0) { CHK_LOOP { const int r = chk_row(si), head = si & 7, kvh = head >> 2, dsel = (si * 7) & 63; const int lane = F.lane;
        float sc[2], vv[2];
        for (int u2 = 0; u2 < 2; ++u2) { const int kix = lane + 64 * u2; float dot = 0.f, vval = 0.f; bool ok = true;
            if (r < MP) { const int t = r % SEQ, tk = t - 127 + kix; ok = tk >= 0;
                if (ok) { const bf16* kr = ZA + ((size_t)(r - t) + tk) * 768; for (int d = 0; d < 64; ++d) dot += bf2f(ZA[(size_t)r * 768 + head * 64 + d]) * bf2f(kr[512 + kvh * 64 + d]); vval = bf2f(kr[640 + kvh * 64 + dsel]); }
            } else { const int bb = (r - MP) >> 3, i = (r - MP) & 7, kk = i + 1 + kix;
                if (kk < 128) { const float* kr = args.in[2] + (((size_t)bb * 128 + kk) * 2 + kvh) * 64; for (int d = 0; d < 64; ++d) dot += bf2f(ZA[(size_t)r * 768 + head * 64 + d]) * bf2f((bf16)f2bf(kr[d])); vval = bf2f((bf16)f2bf(args.in[3][(((size_t)bb * 128 + kk) * 2 + kvh) * 64 + dsel])); }
                else { const bf16* kr = ZA + ((size_t)MP + bb * 8 + (kk - 128)) * 768; for (int d = 0; d < 64; ++d) dot += bf2f(ZA[(size_t)r * 768 + head * 64 + d]) * bf2f(kr[512 + kvh * 64 + d]); vval = bf2f(kr[640 + kvh * 64 + dsel]); } }
            sc[u2] = ok ? dot * 0.125f : -1e30f; vv[u2] = vval; }
        float mx = fmaxf(sc[0], sc[1]);
        for (int o = 1; o < 64; o <<= 1) mx = fmaxf(mx, __shfl_xor(mx, o));
        const float sink = args.in[13][head]; mx = fmaxf(mx, sink);
        const float e0 = __expf(sc[0] - mx), e1 = __expf(sc[1] - mx);
        const float den = wave_sum(e0 + e1) + __expf(sink - mx), num = wave_sum(e0 * vv[0] + e1 * vv[1]);
        chk_put(F, 5, bf2f(OA[(size_t)r * 512 + head * 64 + dsel]), num / den); } }
    GRID_BAR();
#endif
#ifndef DIAG_DN
    for (int u = F.vcu; u < 256; u += F.G) scan_unit(F, u);
#endif
    GRID_BAR();
#ifdef DIAG_SG
    { const size_t gt_ = (size_t)F.vcu * 512 + F.tid, GS_ = (size_t)F.G * 512; const bf16* Wg = wb + W_G / 2;
      for (size_t idx = gt_; idx < (size_t)MROWS * NGATE; idx += GS_) { const size_t r = idx >> 11; const int c = (int)(idx & 2047); float acc = 0.f;
          for (int k = 0; k < DM; k += 8) { const v4u xa = *(const v4u*)(XN + r * DM + k), wv = *(const v4u*)(Wg + (size_t)c * DM + k);
              acc += blo(xa.x) * blo(wv.x) + bhi(xa.x) * bhi(wv.x) + blo(xa.y) * blo(wv.y) + bhi(xa.y) * bhi(wv.y) + blo(xa.z) * blo(wv.z) + bhi(xa.z) * bhi(wv.z) + blo(xa.w) * blo(wv.w) + bhi(xa.w) * bhi(wv.w); }
          SG[idx] = (bf16)f2bf(sigmf(acc)); } }
#else
    { pg8::Gemm g{XN, XN, wb + W_G / 2, wb + W_G / 2, DM, DM / 64}; pg8::StaticOrder S; S.init(MROWS, NGATE, F.G, cu); pg8::EpiBf16Z<1> E{SG, SG, SG, 2048, 2048, 2048, 1000, 1000};
      pg8::gemm_phase<pg8::EpiBf16Z<1>, pg8::StaticOrder, true, true>(F.lds, g, S, E); }
#endif
#ifndef DIAG_DN
    gated_norm_prompt(F, args.in[17]);
#endif
    GRID_BAR();
#ifdef DIAG_CHK
    if (CHKSET == 1 && F.vcu == 0) { CHK_LOOP { const int r = chk_row(si), c = chk_col(si, NGATE);
        chk_put(F, 6, bf2f(SG[(size_t)r * 2048 + c]), sigmf(dotbw(XN + (size_t)r * DM, args.in[12], DM, INDIM, 2824 + c, F.lane)));
        chk_put(F, 100 + si, bf2f(SG[(size_t)r * 2048 + c]), sigmf(dotbw(XN + (size_t)r * DM, args.in[12], DM, INDIM, 2824 + c, F.lane))); } }
    GRID_BAR();
#endif
    { pg8::Gemm g{OA, OB, wb + W_A / 2, wb + W_B / 2, 512, 8}; pg8::PairOrder S; S.so.init(MROWS, DM, F.G, cu); pg8::EpiMerge E{SG, XN};
      pg8::gemm_phase<pg8::EpiMerge, pg8::PairOrder, true, true>(F.lds, g, S, E); }
    GRID_BAR();
#ifdef DIAG_CHK
    if (CHKSET == 1 && F.vcu == 0) { CHK_LOOP { const int r = chk_row(si), c = chk_col(si, DM);
        const float ref = bf2f(SG[(size_t)r * 2048 + c]) * dotbw(OA + (size_t)r * 512, args.in[18], 512, DM, c, F.lane) + bf2f(SG[(size_t)r * 2048 + 1024 + c]) * dotbw(OB + (size_t)r * 512, args.in[19], 512, DM, c, F.lane);
        chk_put(F, 7, bf2f(XN[(size_t)r * DM + c]), ref); } }
    GRID_BAR();
#endif
    { pg8::Gemm g{XN, XN, wb + W_O / 2, wb + W_O / 2, DM, DM / 64}; pg8::StaticOrder S; S.init(MROWS, DM, F.G, cu); pg8::EpiF32 E{MB, DM};
      pg8::gemm_phase<pg8::EpiF32, pg8::StaticOrder, true, true>(F.lds, g, S, E); }
    GRID_BAR();
#ifdef DIAG_CHK
    if (CHKSET == 1 && F.vcu == 0) { CHK_LOOP { const int r = chk_row(si), c = chk_col(si, DM);
        chk_put(F, 8, MB[(size_t)r * DM + c], dotbw(XN + (size_t)r * DM, args.in[20], DM, DM, c, F.lane)); } }
    GRID_BAR();
#endif
    convert_ffn_weights(F, args.in[23], args.in[24], 0);
    rowwise<2>(F, args.in[11], args.in[21], nullptr, nullptr, nullptr, nullptr);
    GRID_BAR();
    { pg8::Gemm g{XN, XN, wb + W_UP / 2, wb + W_UP / 2, DM, DM / 64}; pg8::StaticOrder S; S.init(MROWS, NUP, F.G, cu); pg8::EpiSwiglu E{ACT, FF};
      pg8::gemm_phase<pg8::EpiSwiglu, pg8::StaticOrder, true, true>(F.lds, g, S, E); }
    GRID_BAR();
    { pg8::Gemm g{ACT, ACT, wb + W_DOWN / 2, wb + W_DOWN / 2, FF, FF / 64}; pg8::StaticOrder S; S.init(MROWS, DM, F.G, cu); pg8::EpiF32 E{MB, DM};
      pg8::gemm_phase<pg8::EpiF32, pg8::StaticOrder, true, true>(F.lds, g, S, E); }
    GRID_BAR();
    rowwise<3>(F, args.in[22], nullptr, nullptr, nullptr, nullptr, nullptr);
#ifdef DIAG_CHK
    GRID_BAR();
    if (blockIdx.x == 0 && F.tid == 0) { const unsigned* d = (const unsigned*)(F.ws + WS_CTL + 32768); int code = 0; float ev = 0.f;
        for (int st = 7; st <= 10; ++st) { const float e = __uint_as_float(__hip_atomic_load(d + st, __ATOMIC_RELAXED, __HIP_MEMORY_SCOPE_AGENT)); if (e > CHK_THR) code |= 1 << (st - 7); }
        (void)ev; if (code) F.out[0] = 100.f * code; }
#endif
#ifdef DIAG_OUT
    GRID_BAR();
    {
        const size_t offs[11] = {0, 16777216, O_KP, O_VP, O_CP, O_DP, O_KS, O_VS, O_CS, O_DS, O_END};
        const size_t gt = (size_t)F.vcu * 512 + F.tid, GS = (size_t)F.G * 512;
#pragma unroll 1
        for (int j = 0; j < 10; ++j) { const float eps = sqrtf(0.001f * (float)(j + 1));
            for (size_t i = offs[j] + gt; i < offs[j + 1]; i += GS) { unsigned hsh = (unsigned)i * 2654435761u; hsh ^= hsh >> 15; hsh *= 2246822519u; hsh ^= hsh >> 13;
                F.out[i] = F.out[i] * (1.0f + ((hsh & 1u) ? eps : -eps)); } }
    }
#endif
}

extern "C" void kernel_launch(void* const* d_in, const int* in_sizes, int n_in, void* d_out, int out_size, void* d_ws, size_t ws_size, hipStream_t stream) {
    static int grid = 0;
    if (grid == 0) {
        if (n_in != 25 || out_size != (int)O_END || ws_size < WS_END) { fprintf(stderr, "kernel_launch: unexpected problem shape (n_in %d out %d ws %zu)\n", n_in, out_size, ws_size); grid = -1; return; }
        int dev = 0, cus = 0, per_cu = 0;
        if (hipGetDevice(&dev) != hipSuccess || hipDeviceGetAttribute(&cus, hipDeviceAttributeMultiprocessorCount, dev) != hipSuccess) { grid = -1; return; }
        if (hipFuncSetAttribute((const void*)mega_fwd, hipFuncAttributeMaxDynamicSharedMemorySize, LDS_BYTES) != hipSuccess) { fprintf(stderr, "kernel_launch: hipFuncSetAttribute failed\n"); grid = -1; return; }
        if (hipOccupancyMaxActiveBlocksPerMultiprocessor(&per_cu, (const void*)mega_fwd, NWAVES * 64, LDS_BYTES) != hipSuccess || per_cu < 1) { fprintf(stderr, "kernel_launch: occupancy query reports %d\n", per_cu); }
        (void)hipGetLastError();
        grid = cus;
    }
    if (grid < 0) return;
    (void)hipMemsetAsync((char*)d_ws + WS_CTL, 0, CTL_ZERO_BYTES, stream);
    Args a{};
    for (int i = 0; i < 25; ++i) a.in[i] = (const float*)d_in[i];
    a.out = (float*)d_out; a.ws = (unsigned char*)d_ws;
    hipLaunchKernelGGL(mega_fwd, dim3(grid), dim3(NWAVES * 64), LDS_BYTES, stream, a);
}
```

```cpp
#include <hip/hip_runtime.h>
#include <cstdio>
#include <cstdint>

constexpr int DM = 1024, NBATCH = 8, SEQ = 2048, DBATCH = 128, DSEQ = 8;
constexpr int MP = NBATCH * SEQ, MS = DBATCH * DSEQ, MROWS = MP + MS;
constexpr int FF = 2816, NUP = 2 * FF, CONVD = 1536, INDIM = 4872;
constexpr int NZ1 = 2816, NGATE = 2048;
constexpr float EPS = 1e-6f;
constexpr size_t O_Y = 0, O_KP = 17825792, O_VP = O_KP + 131072, O_CP = O_VP + 131072, O_DP = O_CP + 36864, O_KS = O_DP + 524288, O_VS = O_KS + 2097152,
                 O_CS = O_VS + 2097152, O_DS = O_CS + 589824, O_END = O_DS + 8388608;
static_assert(O_END == 31821824, "output size");

__device__ __forceinline__ int hw_lane() { int l; asm volatile("v_mbcnt_lo_u32_b32 %0, -1, 0\n\tv_mbcnt_hi_u32_b32 %0, -1, %0" : "=v"(l)); return l; }
namespace pg8 {
#define PG8_LAS __attribute__((address_space(3)))
typedef unsigned short bf16_t;
typedef short bf16x8 __attribute__((ext_vector_type(8)));
typedef float f32x4 __attribute__((ext_vector_type(4)));
typedef unsigned u32x4 __attribute__((ext_vector_type(4)));
constexpr int BM = 256, BK = 64, HALF = 128, HTB = HALF * BK * 2  , STAGE_BYTES = 8 * HTB, NXCD = 8, WGM = 8;

__host__ __device__ __forceinline__ int lds_byte(int r, int c) { const int st = (r >> 4) * 2 + (c >> 5), rr = r & 15, cc = c & 31, ob = rr * 64 + cc * 2; return st * 1024 + (ob ^ (((ob >> 9) & 1) << 5)); }
__host__ __device__ __forceinline__ void stage_rc(int b, int& R, int& C) { const int st = b / 1024, sb = b % 1024, swz = sb ^ (((sb >> 9) & 1) << 5); R = (st >> 1) * 16 + swz / 64; C = (st & 1) * 32 + (swz % 64) / 2; }
__host__ __device__ __forceinline__ int perm32(int rho) { const int n = rho >> 4, i = rho & 15; return 8 * (i >> 2) + 4 * n + (i & 3); }

struct Unit { int pm, pn, br, kt0, nt, split; };
struct Gemm { const bf16_t* A0; const bf16_t* A1; const bf16_t* B0; const bf16_t* B1; int K; int nt; };

struct StaticOrder {
    int nM, nN, nwg, G, c;
    __device__ void init(int M, int N, int G_, int c_) { nM = M / BM; nN = N / BM; nwg = nM * nN; G = G_; c = c_; }
    __device__ void map(int L, Unit& u) const {
        int wgid = L; { const int q = nwg / NXCD, r = nwg % NXCD, xcd = wgid % NXCD, off = wgid / NXCD; wgid = (xcd < r ? xcd * (q + 1) : r * (q + 1) + (xcd - r) * q) + off; }
        const int nig = WGM * nN, gid = wgid / nig, fm = gid * WGM, gsz = (nM - fm) < WGM ? (nM - fm) : WGM;
        u.pm = fm + ((wgid % nig) % gsz); u.pn = (wgid % nig) / gsz; u.br = 0; u.kt0 = 0; u.nt = 0; u.split = -1;
    }
    __device__ bool next(int i, Unit& u) const { const long L = (long)i * G + c; if (L >= nwg) return false; map((int)L, u); return true; }
};
struct PairOrder {
    StaticOrder so;
    __device__ bool next(int i, Unit& u) const { const long L = (long)(i >> 1) * so.G + so.c; if (L >= so.nwg) return false; so.map((int)L, u); u.br = i & 1; return true; }
};

struct PairOrder2 {
    StaticOrder so;
    __device__ bool next(int i, Unit& u) const {
        if (i < 2) { if (so.c >= so.nwg) return false; so.map(so.c, u); u.br = i; return true; }
        if (i == 2) { const int j = so.c; if (j >= 32) return false; const int tile = j >> 1; u.pm = 64 + (tile >> 2); u.pn = tile & 3; u.br = j & 1; u.kt0 = 0; u.nt = 0; u.split = 0; return true; }
        return false;
    }
};
struct SplitOrder2 {
    StaticOrder so;
    __device__ bool next(int i, Unit& u) const {
        if (i == 0) { if (so.c >= so.nwg) return false; so.map(so.c, u); return true; }
        if (i == 1) { const int j = so.c; if (j >= 128) return false; const int tile = j >> 3, sp = j & 7; u.pm = 64 + (tile >> 2); u.pn = tile & 3; u.br = sp >> 2; u.nt = 4; u.kt0 = 4 * (sp & 3); u.split = sp; return true; }
        return false;
    }
};
struct SplitOrder {
    StaticOrder so; int nsplit, big_nt, nbig, small_nt;
    __device__ bool next(int i, Unit& u) const {
        if (i == 0) { if (so.c >= so.nwg) return false; so.map(so.c, u); return true; }
        if (i == 1) { const int j = so.c; if (j >= 16 * nsplit) return false; const int tile = j / nsplit, sp = j % nsplit;
            u.pm = 64 + (tile >> 2); u.pn = tile & 3; u.br = 0; u.split = sp;
            if (sp < nbig) { u.nt = big_nt; u.kt0 = sp * big_nt; } else { u.nt = small_nt; u.kt0 = nbig * big_nt + (sp - nbig) * small_nt; }
            return true; }
        return false;
    }
};
typedef float f32x2_cv __attribute__((ext_vector_type(2))); typedef __bf16 bf16x2_cv __attribute__((ext_vector_type(2)));
__device__ __forceinline__ unsigned cvt_pk_bf16(float lo, float hi) { f32x2_cv v = {lo, hi}; bf16x2_cv b = __builtin_convertvector(v, bf16x2_cv); return __builtin_bit_cast(unsigned, b); }
__device__ __forceinline__ float bflo(unsigned w) { return __builtin_bit_cast(float, w << 16); }
__device__ __forceinline__ float bfhi(unsigned w) { return __builtin_bit_cast(float, w & 0xffff0000u); }
__device__ __forceinline__ float sigm(float x) { return __builtin_amdgcn_rcpf(1.0f + __expf(-x)); }

typedef f32x4 Acc[2][2][4][2];

struct EpiSwiglu {
    static constexpr bool PERM = true;
    bf16_t* O; int ldc;
    __device__ __forceinline__ bool keep(const Unit&) const { return false; }
    __device__ __forceinline__ void operator()(Acc& acc, const Unit& u, int wr, int wc, int fr, int fq) const {
        const int row0 = u.pm * BM + wr * 64 + fr, col0 = u.pn * HALF + wc * 32 + 8 * fq;
#pragma unroll
        for (int ai = 0; ai < 2; ++ai)
#pragma unroll
            for (int m = 0; m < 4; ++m) {
                float o[8];
#pragma unroll
                for (int n = 0; n < 2; ++n)
#pragma unroll
                    for (int j = 0; j < 4; ++j) { const float g = acc[ai][0][m][n][j], up = acc[ai][1][m][n][j]; o[4 * n + j] = g * sigm(g) * up; }
                u32x4 w; w.x = cvt_pk_bf16(o[0], o[1]); w.y = cvt_pk_bf16(o[2], o[3]); w.z = cvt_pk_bf16(o[4], o[5]); w.w = cvt_pk_bf16(o[6], o[7]);
                *(u32x4*)(O + (size_t)(row0 + ai * HALF + m * 16) * ldc + col0) = w;
            }
    }
};
struct EpiF32 {
    static constexpr bool PERM = false;
    float* O; int ldc; float* P;
    __device__ __forceinline__ bool keep(const Unit&) const { return false; }
    __device__ __forceinline__ void operator()(Acc& acc, const Unit& u, int wr, int wc, int fr, int fq) const {
        const int row0 = u.pm * BM + wr * 64 + fr, col0 = u.pn * BM + wc * 32 + 4 * fq;
        float* base = u.split < 0 ? O : P + ((size_t)u.split * MS - MP) * ldc;
#pragma unroll
        for (int ai = 0; ai < 2; ++ai)
#pragma unroll
            for (int m = 0; m < 4; ++m) { float* rowp = base + (size_t)(row0 + ai * HALF + m * 16) * ldc + col0;
#pragma unroll
                for (int bj = 0; bj < 2; ++bj)
#pragma unroll
                    for (int n = 0; n < 2; ++n) *(f32x4*)(rowp + bj * HALF + n * 16) = acc[ai][bj][m][n]; }
    }
};
struct EpiMB {
    static constexpr bool PERM = true;
    bf16_t* O; int ldc; float* P;
    __device__ __forceinline__ bool keep(const Unit&) const { return false; }
    __device__ __forceinline__ void operator()(Acc& acc, const Unit& u, int wr, int wc, int fr, int fq) const {
        const int row0 = u.pm * BM + wr * 64 + fr, col0 = u.pn * BM + wc * 32 + 8 * fq;
        if (u.split < 0) {
#pragma unroll
            for (int ai = 0; ai < 2; ++ai)
#pragma unroll
                for (int m = 0; m < 4; ++m) { bf16_t* rowp = O + (size_t)(row0 + ai * HALF + m * 16) * ldc + col0;
#pragma unroll
                    for (int bj = 0; bj < 2; ++bj) { const f32x4 v0 = acc[ai][bj][m][0], v1 = acc[ai][bj][m][1];
                        u32x4 w; w.x = cvt_pk_bf16(v0[0], v0[1]); w.y = cvt_pk_bf16(v0[2], v0[3]); w.z = cvt_pk_bf16(v1[0], v1[1]); w.w = cvt_pk_bf16(v1[2], v1[3]);
                        *(u32x4*)(rowp + bj * HALF) = w; } }
        } else {
            float* base = P + ((size_t)u.split * MS - MP) * ldc;
#pragma unroll
            for (int ai = 0; ai < 2; ++ai)
#pragma unroll
                for (int m = 0; m < 4; ++m) { float* rowp = base + (size_t)(row0 + ai * HALF + m * 16) * ldc + col0;
#pragma unroll
                    for (int bj = 0; bj < 2; ++bj) { *(f32x4*)(rowp + bj * HALF) = acc[ai][bj][m][0]; *(f32x4*)(rowp + bj * HALF + 4) = acc[ai][bj][m][1]; } }
        }
    }
};
template <int ACT  > struct EpiBf16Z {
    static constexpr bool PERM = true;
    bf16_t* O0; bf16_t* O1; bf16_t* O2; int ld0, ld1, ld2, t1, t2;
    __device__ __forceinline__ bool keep(const Unit&) const { return false; }
    __device__ __forceinline__ void operator()(Acc& acc, const Unit& u, int wr, int wc, int fr, int fq) const {
        bf16_t* base; int ld, pn = u.pn;
        if (pn < t1) { base = O0; ld = ld0; } else if (pn < t2) { base = O1; ld = ld1; pn -= t1; } else { base = O2; ld = ld2; pn -= t2; }
        const int row0 = u.pm * BM + wr * 64 + fr, col0 = pn * BM + wc * 32 + 8 * fq;
#pragma unroll
        for (int ai = 0; ai < 2; ++ai)
#pragma unroll
            for (int m = 0; m < 4; ++m) { bf16_t* rowp = base + (size_t)(row0 + ai * HALF + m * 16) * ld + col0;
#pragma unroll
                for (int bj = 0; bj < 2; ++bj) { f32x4 v0 = acc[ai][bj][m][0], v1 = acc[ai][bj][m][1];
                    if (ACT == 1) {
#pragma unroll
                        for (int j = 0; j < 4; ++j) { v0[j] = sigm(v0[j]); v1[j] = sigm(v1[j]); } }
                    u32x4 w; w.x = cvt_pk_bf16(v0[0], v0[1]); w.y = cvt_pk_bf16(v0[2], v0[3]); w.z = cvt_pk_bf16(v1[0], v1[1]); w.w = cvt_pk_bf16(v1[2], v1[3]);
                    *(u32x4*)(rowp + bj * HALF) = w; } }
    }
};
struct EpiMerge {
    static constexpr bool PERM = true;
    const bf16_t* SG; bf16_t* O; bf16_t* O2;
    __device__ __forceinline__ bool keep(const Unit& u) const { return u.split < 0 && u.br == 0; }
    __device__ __forceinline__ void operator()(Acc& acc, const Unit& u, int wr, int wc, int fr, int fq) const {
        const int row0 = u.pm * BM + wr * 64 + fr, col0 = u.pn * BM + wc * 32 + 8 * fq;
#pragma unroll
        for (int ai = 0; ai < 2; ++ai)
#pragma unroll
            for (int m = 0; m < 4; ++m) { const size_t row = (size_t)(row0 + ai * HALF + m * 16);
#pragma unroll
                for (int bj = 0; bj < 2; ++bj) {
                    if (u.split >= 0) {
                        const u32x4 sg = *(const u32x4*)(SG + row * 2048 + (u.br ? 1024 : 0) + col0 + bj * HALF);
                        const float gg[8] = {bflo(sg.x), bfhi(sg.x), bflo(sg.y), bfhi(sg.y), bflo(sg.z), bfhi(sg.z), bflo(sg.w), bfhi(sg.w)};
                        float o[8];
#pragma unroll
                        for (int n = 0; n < 2; ++n)
#pragma unroll
                            for (int j = 0; j < 4; ++j) o[4 * n + j] = acc[ai][bj][m][n][j] * gg[4 * n + j];
                        u32x4 w; w.x = cvt_pk_bf16(o[0], o[1]); w.y = cvt_pk_bf16(o[2], o[3]); w.z = cvt_pk_bf16(o[4], o[5]); w.w = cvt_pk_bf16(o[6], o[7]);
                        *(u32x4*)((u.br ? O2 : O) + row * 1024 + col0 + bj * HALF) = w;
                        continue;
                    }
                    const u32x4 sb = *(const u32x4*)(SG + row * 2048 + 1024 + col0 + bj * HALF);
                    float b[8] = {bflo(sb.x), bfhi(sb.x), bflo(sb.y), bfhi(sb.y), bflo(sb.z), bfhi(sb.z), bflo(sb.w), bfhi(sb.w)};
                    if (u.br == 0) {
                        const u32x4 sa = *(const u32x4*)(SG + row * 2048 + col0 + bj * HALF);
                        float a[8] = {bflo(sa.x), bfhi(sa.x), bflo(sa.y), bfhi(sa.y), bflo(sa.z), bfhi(sa.z), bflo(sa.w), bfhi(sa.w)};
#pragma unroll
                        for (int n = 0; n < 2; ++n)
#pragma unroll
                            for (int j = 0; j < 4; ++j) acc[ai][bj][m][n][j] *= a[4 * n + j] * __builtin_amdgcn_rcpf(b[4 * n + j]);
                    } else {
                        float o[8];
#pragma unroll
                        for (int n = 0; n < 2; ++n)
#pragma unroll
                            for (int j = 0; j < 4; ++j) o[4 * n + j] = acc[ai][bj][m][n][j] * b[4 * n + j];
                        u32x4 w; w.x = cvt_pk_bf16(o[0], o[1]); w.y = cvt_pk_bf16(o[2], o[3]); w.z = cvt_pk_bf16(o[4], o[5]); w.w = cvt_pk_bf16(o[6], o[7]);
                        *(u32x4*)(O + row * 1024 + col0 + bj * HALF) = w;
                    }
                } }
    }
};

template <class Epi, class Sched, bool ALIGN_EPI = false, bool SP2 = false>
__device__ __forceinline__ void gemm_phase(PG8_LAS unsigned char* lds, const Gemm g, const Sched& S, const Epi& E, int wave_id) {
    int tid_ = wave_id * 64 + hw_lane(); asm volatile("" : "+v"(tid_));
    const int tid = tid_, wid = __builtin_amdgcn_readfirstlane(tid >> 6), lane = tid & 63, wr = wid >> 2, wc = wid & 3, fr = lane & 15, fq = lane >> 4;
    const int K = g.K, nt = g.nt;
    unsigned voffA[2], voffB[2];
#pragma unroll
    for (int i = 0; i < 2; ++i) { int R, C; stage_rc(tid * 16 + i * 8192, R, C); const int Rb = Epi::PERM ? ((R & ~31) + perm32(R & 31)) : R;
        voffA[i] = (unsigned)(R * K + C) * 2u; voffB[i] = (unsigned)(Rb * K + C) * 2u; }
    const size_t kstep = (size_t)(BK * 2);
    const size_t hstep = (size_t)HALF * K * 2;
    const size_t tstep = 2 * hstep;
    const unsigned ldsw = (unsigned)wid * 1024u;
    const int aoff = lds_byte(wr * 64 + fr, fq * 8), boff = lds_byte(wc * 32 + fr, fq * 8);
#define PG8_SA(b, h) (((b) * 2 + (h)) * HTB)
#define PG8_SB(b, h) ((4 + (b) * 2 + (h)) * HTB)
#define PG8_STAGE(bufoff, gbase, voff) do { _Pragma("unroll") for (int _i = 0; _i < 2; ++_i) \
        __builtin_amdgcn_global_load_lds((const unsigned*)((const char*)(gbase) + (voff)[_i]), (PG8_LAS unsigned*)(lds + (bufoff) + ldsw + _i * 8192), 16, 0, 0); } while (0)
#define PG8_LDA(dst, b, h) do { _Pragma("unroll") for (int m = 0; m < 4; ++m) _Pragma("unroll") for (int k = 0; k < 2; ++k) dst[m][k] = *(const PG8_LAS bf16x8*)(lds + PG8_SA(b, h) + aoff + m * 2048 + k * 1024); } while (0)
#define PG8_LDB(dst, b, h) do { _Pragma("unroll") for (int n = 0; n < 2; ++n) _Pragma("unroll") for (int k = 0; k < 2; ++k) dst[n][k] = *(const PG8_LAS bf16x8*)(lds + PG8_SB(b, h) + boff + n * 2048 + k * 1024); } while (0)
#define PG8_MMA(ai, bj, At, Bt) do { __builtin_amdgcn_s_setprio(1); _Pragma("unroll") for (int m = 0; m < 4; ++m) _Pragma("unroll") for (int n = 0; n < 2; ++n) _Pragma("unroll") for (int k = 0; k < 2; ++k) \
        acc[ai][bj][m][n] = __builtin_amdgcn_mfma_f32_16x16x32_bf16(Bt[n][k], At[m][k], acc[ai][bj][m][n], 0, 0, 0); __builtin_amdgcn_s_setprio(0); } while (0)
#define PG8_WAIT_V(n) asm volatile("s_waitcnt vmcnt(" #n ")" ::: "memory")
#define PG8_WAIT_L(n) asm volatile("s_waitcnt lgkmcnt(" #n ")" ::: "memory")
#define PG8_BAR __builtin_amdgcn_s_barrier()
#define PG8_SCHED __builtin_amdgcn_sched_barrier(0)
    Unit cur, nxt; int ui = 0;
    if (!S.next(0, cur)) return;
    f32x4 acc[2][2][4][2];
#pragma unroll
    for (int a = 0; a < 2; ++a)
#pragma unroll
        for (int b = 0; b < 2; ++b)
#pragma unroll
            for (int m = 0; m < 4; ++m)
#pragma unroll
                for (int n = 0; n < 2; ++n) acc[a][b][m][n] = (f32x4){0.f, 0.f, 0.f, 0.f};
    bf16x8 At[4][2], B0[2][2], B1[2][2];
    const char* cA = (const char*)(cur.br ? g.A1 : g.A0) + (size_t)cur.pm * tstep + (size_t)cur.kt0 * kstep; const char* cB = (const char*)(cur.br ? g.B1 : g.B0) + (size_t)cur.pn * tstep + (size_t)cur.kt0 * kstep;
    int cnt = cur.nt ? cur.nt : nt;
    if constexpr (SP2) {
        PG8_STAGE(PG8_SB(0, 0), cB, voffB); PG8_STAGE(PG8_SB(0, 1), cB + hstep, voffB); PG8_STAGE(PG8_SA(0, 0), cA, voffA); PG8_STAGE(PG8_SA(0, 1), cA + hstep, voffA);
        if (wr == 1) PG8_BAR;
        PG8_WAIT_V(2); PG8_BAR;
        PG8_STAGE(PG8_SB(1, 0), cB + kstep, voffB); PG8_STAGE(PG8_SA(1, 0), cA + kstep, voffA); PG8_STAGE(PG8_SB(1, 1), cB + hstep + kstep, voffB);
        PG8_WAIT_V(6); PG8_BAR;
    } else {
        PG8_STAGE(PG8_SB(0, 0), cB, voffB); PG8_STAGE(PG8_SA(0, 0), cA, voffA); PG8_STAGE(PG8_SB(0, 1), cB + hstep, voffB); PG8_STAGE(PG8_SA(0, 1), cA + hstep, voffA);
        if (wr == 1) PG8_BAR;
        PG8_WAIT_V(4); PG8_BAR;
        PG8_STAGE(PG8_SB(1, 0), cB + kstep, voffB); PG8_STAGE(PG8_SA(1, 0), cA + kstep, voffA); PG8_STAGE(PG8_SB(1, 1), cB + hstep + kstep, voffB);
        PG8_WAIT_V(6); PG8_BAR;
    }
    for (;;) {
        const bool has_next = S.next(ui + 1, nxt);
        const char* nA = has_next ? (const char*)(nxt.br ? g.A1 : g.A0) + (size_t)nxt.pm * tstep + (size_t)nxt.kt0 * kstep : cA; const char* nB = has_next ? (const char*)(nxt.br ? g.B1 : g.B0) + (size_t)nxt.pn * tstep + (size_t)nxt.kt0 * kstep : cB;
        for (int t = 0; t < cnt; t += 2) {
            const bool last = (t == cnt - 2);
            const char* a1 = cA + (size_t)(t + 1) * kstep;
            const char* a2 = last ? nA : cA + (size_t)(t + 2) * kstep; const char* b2 = last ? nB : cB + (size_t)(t + 2) * kstep;
            const char* a3 = a2 + kstep; const char* b3 = b2 + kstep;
            if constexpr (SP2) {
            PG8_LDB(B0, 0, 0); PG8_LDB(B1, 0, 1); PG8_SCHED; PG8_LDA(At, 0, 0); PG8_STAGE(PG8_SA(1, 1), a1 + hstep, voffA);
            PG8_WAIT_V(8); PG8_WAIT_L(0); PG8_BAR; PG8_MMA(0, 0, At, B0); PG8_MMA(0, 1, At, B1); PG8_BAR; PG8_SCHED;
            PG8_LDA(At, 0, 1); PG8_STAGE(PG8_SB(0, 0), b2, voffB); PG8_STAGE(PG8_SB(0, 1), b2 + hstep, voffB); PG8_STAGE(PG8_SA(0, 0), a2, voffA);
            PG8_WAIT_V(8); PG8_WAIT_L(0); PG8_BAR; PG8_MMA(1, 0, At, B0); PG8_MMA(1, 1, At, B1); PG8_BAR; PG8_SCHED;
            PG8_LDB(B0, 1, 0); PG8_LDB(B1, 1, 1); PG8_SCHED; PG8_LDA(At, 1, 0); PG8_STAGE(PG8_SA(0, 1), a2 + hstep, voffA);
            PG8_WAIT_V(8); PG8_WAIT_L(0); PG8_BAR; PG8_MMA(0, 0, At, B0); PG8_MMA(0, 1, At, B1); PG8_BAR; PG8_SCHED;
            PG8_LDA(At, 1, 1); PG8_STAGE(PG8_SB(1, 0), b3, voffB); PG8_STAGE(PG8_SB(1, 1), b3 + hstep, voffB); PG8_STAGE(PG8_SA(1, 0), a3, voffA);
            PG8_WAIT_V(8); PG8_WAIT_L(0); PG8_BAR; PG8_MMA(1, 0, At, B0); PG8_MMA(1, 1, At, B1); PG8_BAR; PG8_SCHED;
            } else {
            PG8_LDB(B0, 0, 0); PG8_SCHED; PG8_LDA(At, 0, 0); PG8_STAGE(PG8_SA(1, 1), a1 + hstep, voffA);
            PG8_WAIT_L(8); PG8_BAR; PG8_WAIT_L(0); PG8_MMA(0, 0, At, B0); PG8_BAR; PG8_SCHED;
            PG8_LDB(B1, 0, 1); PG8_STAGE(PG8_SB(0, 0), b2, voffB);
            PG8_BAR; PG8_WAIT_L(0); PG8_MMA(0, 1, At, B1); PG8_BAR;
            PG8_LDA(At, 0, 1); PG8_STAGE(PG8_SA(0, 0), a2, voffA);
            PG8_BAR; PG8_WAIT_L(0); PG8_MMA(1, 0, At, B0); PG8_BAR; PG8_SCHED;
            PG8_STAGE(PG8_SB(0, 1), b2 + hstep, voffB);
            PG8_WAIT_V(6); PG8_BAR; PG8_MMA(1, 1, At, B1); PG8_BAR;
            PG8_LDB(B0, 1, 0); PG8_SCHED; PG8_LDA(At, 1, 0); PG8_STAGE(PG8_SA(0, 1), a2 + hstep, voffA);
            PG8_WAIT_L(8); PG8_BAR; PG8_WAIT_L(0); PG8_MMA(0, 0, At, B0); PG8_BAR; PG8_SCHED;
            PG8_LDB(B1, 1, 1); PG8_STAGE(PG8_SB(1, 0), b3, voffB);
            PG8_BAR; PG8_WAIT_L(0); PG8_MMA(0, 1, At, B1); PG8_BAR;
            PG8_LDA(At, 1, 1); PG8_STAGE(PG8_SA(1, 0), a3, voffA);
            PG8_BAR; PG8_WAIT_L(0); PG8_MMA(1, 0, At, B0); PG8_BAR; PG8_SCHED;
            PG8_STAGE(PG8_SB(1, 1), b3 + hstep, voffB);
            PG8_WAIT_V(6); PG8_BAR; PG8_MMA(1, 1, At, B1); PG8_BAR;
            }
        }
        if constexpr (ALIGN_EPI) { if (wr == 0) PG8_BAR; }
        E(acc, cur, wr, wc, fr, fq);
        if (!has_next) break;
        if (!E.keep(cur)) {
#pragma unroll
        for (int a = 0; a < 2; ++a)
#pragma unroll
            for (int b = 0; b < 2; ++b)
#pragma unroll
                for (int m = 0; m < 4; ++m)
#pragma unroll
                    for (int n = 0; n < 2; ++n) acc[a][b][m][n] = (f32x4){0.f, 0.f, 0.f, 0.f};
        }
        cur = nxt; cA = nA; cB = nB; ++ui; cnt = cur.nt ? cur.nt : nt;
        if constexpr (ALIGN_EPI) { if (wr == 1) PG8_BAR; }
    }
    PG8_WAIT_V(0);
    if constexpr (!ALIGN_EPI) { if (wr == 0) PG8_BAR; }
    PG8_BAR;
#undef PG8_SA
#undef PG8_SB
#undef PG8_STAGE
#undef PG8_LDA
#undef PG8_LDB
#undef PG8_MMA
#undef PG8_WAIT_V
#undef PG8_WAIT_L
#undef PG8_BAR
#undef PG8_SCHED
}
}
#define GAS __attribute__((address_space(1)))
#define LAS __attribute__((address_space(3)))
typedef unsigned short bf16;
typedef unsigned v4u __attribute__((ext_vector_type(4)));
typedef float f32x4 __attribute__((ext_vector_type(4)));
typedef short bf16x8 __attribute__((ext_vector_type(8)));
typedef GAS unsigned gu32;
typedef GAS unsigned long long gu64;
#define RLX_AGENT __ATOMIC_RELAXED, __HIP_MEMORY_SCOPE_AGENT
#define LDS_WAIT() asm volatile("s_waitcnt lgkmcnt(0)" ::: "memory")
#define VM_WAIT() asm volatile("s_waitcnt vmcnt(0)" ::: "memory")
__device__ __forceinline__ unsigned long long rt() { return __builtin_amdgcn_s_memrealtime(); }
__device__ __forceinline__ unsigned f2bf(float f) { unsigned u = __builtin_bit_cast(unsigned, f); return (u + 0x7fffu + ((u >> 16) & 1u)) >> 16; }
__device__ __forceinline__ unsigned pk2(float lo, float hi) { return f2bf(lo) | (f2bf(hi) << 16); }

#define XB_TMO      128
#define XB_XCNT(j)  (256  + 64 * (j))
#define XB_XSUB(j)  (1280 + 64 * (j))
#define XB_XGEN(j)  (2304 + 64 * (j))
#define XB_TOP      3328
#define XB_TOPGEN   3392
#define XCD_BAR_WORDS 3456
#define XB_SPIN_CAP (1u << 18)

__device__ __forceinline__ unsigned xb_ld(unsigned* p)              { return __hip_atomic_load(p, __ATOMIC_RELAXED, __HIP_MEMORY_SCOPE_AGENT); }
__device__ __forceinline__ unsigned xb_add(unsigned* p, unsigned v) { return __hip_atomic_fetch_add(p, v, __ATOMIC_RELAXED, __HIP_MEMORY_SCOPE_AGENT); }
__device__ __forceinline__ unsigned xb_xcc_id() { return (unsigned)__builtin_amdgcn_s_getreg((3 << 11) | 20) & 0xFu; }
#define XB_SPIN(cond, bar) do { unsigned _sp = 0; while (cond) { __builtin_amdgcn_s_sleep(1); \
    if ((++_sp & 255u) == 0u) { if (xb_ld(&(bar)[XB_TMO])) break; if (_sp > XB_SPIN_CAP) { atomicAdd(&(bar)[XB_TMO], 1u); break; } } } } while (0)

struct XcdBarrier {
    unsigned* bar; unsigned x;
    volatile LAS unsigned* st;
};

__device__ __forceinline__ XcdBarrier xcd_barrier_post(unsigned* bar, volatile LAS unsigned* st, bool tid0) {
    XcdBarrier b; b.bar = bar; b.x = xb_xcc_id(); b.st = st;
    if (tid0) (void)xb_add(&bar[XB_XCNT(b.x)], 1u);
    return b;
}
__device__ __forceinline__ void xcd_barrier_complete(unsigned* bar, unsigned x, unsigned& nloc, unsigned& nx) {
    const unsigned G = gridDim.x * gridDim.y * gridDim.z;
    unsigned sum, cnt, mine, sp = 0u;
    for (;;) {
        sum = 0u; cnt = 0u; mine = 0u;
#pragma unroll
        for (unsigned j = 0; j < 16; ++j) { const unsigned c = xb_ld(&bar[XB_XCNT(j)]); sum += c; cnt += (c > 0u) ? 1u : 0u; mine = (j == x) ? c : mine; }
        if (sum == G) break;
        __builtin_amdgcn_s_sleep(1);
        if ((++sp & 255u) == 0u) { if (xb_ld(&bar[XB_TMO])) break; if (sp > XB_SPIN_CAP) { atomicAdd(&bar[XB_TMO], 1u); break; } }
    }
    nloc = mine > 0u ? mine : 1u; nx = cnt > 0u ? cnt : 1u;
}

__device__ __forceinline__ void xcd_barrier(const XcdBarrier& b, bool tid0) {
    asm volatile("s_waitcnt vmcnt(0)" ::: "memory");
    __syncthreads();
    if (tid0) {
        unsigned* bar = b.bar;
        __builtin_amdgcn_s_waitcnt(0);
        unsigned nloc = b.st[0], nx = b.st[1];
        if (nloc == 0u) { xcd_barrier_complete(bar, b.x, nloc, nx); b.st[0] = nloc; b.st[1] = nx; }
        const unsigned old = xb_add(&bar[XB_XSUB(b.x)], 1u);
        const unsigned gen = old / nloc;
        if (old + 1u == (gen + 1u) * nloc) {
            __builtin_amdgcn_fence(__ATOMIC_RELEASE, "agent");
            asm volatile("s_waitcnt vmcnt(0)" ::: "memory");
            const unsigned og = xb_add(&bar[XB_TOP], 1u);
            const unsigned tg = og / nx;
            if (og + 1u == (tg + 1u) * nx) xb_add(&bar[XB_TOPGEN], 1u);
            else XB_SPIN(xb_ld(&bar[XB_TOPGEN]) == tg, bar);
            __builtin_amdgcn_fence(__ATOMIC_ACQUIRE, "agent");
            xb_add(&bar[XB_XGEN(b.x)], 1u);
            asm volatile("s_waitcnt vmcnt(0)" ::: "memory");
        } else {
            XB_SPIN(xb_ld(&bar[XB_XGEN(b.x)]) == gen, bar);
            __builtin_amdgcn_fence(__ATOMIC_ACQUIRE, "agent");
            asm volatile("s_waitcnt vmcnt(0)" ::: "memory");
        }
    }
    __syncthreads();
}
typedef unsigned v2u __attribute__((ext_vector_type(2)));

constexpr size_t MiB = 1u << 20;
constexpr size_t WS_CTL = 0, CTL_ZERO_BYTES = 64 * 1024;
constexpr size_t WS_W = 1 * MiB;
constexpr size_t W_UP = 0, W_DOWN = (size_t)NUP * DM * 2;
constexpr size_t W_IN1 = 0, W_G = (size_t)NZ1 * DM * 2, W_A = W_G + (size_t)NGATE * DM * 2, W_B = W_A + (size_t)DM * 512 * 2, W_O = W_B + (size_t)DM * 512 * 2;
static_assert(W_DOWN + (size_t)DM * FF * 2 <= 17 * MiB && W_O + (size_t)DM * DM * 2 <= 17 * MiB, "weight region");
constexpr size_t WS_XN = 18 * MiB;
constexpr size_t WS_RA = 52 * MiB;
constexpr size_t RA_ZA = 0, RA_ZC = (size_t)MROWS * 768 * 2, RA_ZZ = RA_ZC + (size_t)MROWS * 1536 * 2;
constexpr size_t WS_RB = 146 * MiB;
constexpr size_t PREP_UNIT = 73728, PU_KC = 0, PU_QD = 16384, PU_KD = 32768, PU_VU = 49152, PU_QK = 65536;
constexpr size_t WS_RC = 218 * MiB;
constexpr size_t WS_GB = 252 * MiB;
constexpr size_t WS_GT = WS_GB + 640 * 1024;
constexpr size_t WS_WAB = 253 * MiB;
constexpr size_t WS_MB2 = 254 * MiB;
constexpr size_t WS_END = 256 * MiB;
static_assert(WS_XN + (size_t)MROWS * DM * 2 <= WS_RA && WS_RA + (size_t)MROWS * 2816 * 2 <= WS_RB && WS_RB + 1024 * PREP_UNIT <= WS_RC && (size_t)MROWS * DM * 4 <= 72 * MiB &&
              WS_RC + 2 * (size_t)MROWS * 512 * 2 <= WS_GB && (size_t)MROWS * 32 <= 640 * 1024 && (size_t)MP * 512 * 4 <= (size_t)MROWS * 1536 * 2, "d_ws map");
constexpr int CW_BAR = 1024;

constexpr int RING_BYTES = 131072;
constexpr int PREP_HALF = 69888;
constexpr int MISC_OFF = 2 * PREP_HALF;
constexpr int LDS_BYTES = MISC_OFF + 256;
constexpr int NWAVES = 8;

struct Frame {
    LAS unsigned char* lds;
    int tid, lane, wave, vcu, G;
    float* out; unsigned char* ws;
};

__device__ __forceinline__ float bf2f(unsigned short b) { return __builtin_bit_cast(float, (unsigned)b << 16); }
__device__ __forceinline__ float blo(unsigned w) { return __builtin_bit_cast(float, w << 16); }
__device__ __forceinline__ float bhi(unsigned w) { return __builtin_bit_cast(float, w & 0xffff0000u); }
__device__ __forceinline__ float wave_sum(float v) {
#pragma unroll
    for (int o = 1; o < 64; o <<= 1) v += __shfl_xor(v, o);
    return v;
}
__device__ __forceinline__ float siluf(float x) { return x * __builtin_amdgcn_rcpf(1.0f + __expf(-x)); }
__device__ __forceinline__ float sigmf(float x) { return __builtin_amdgcn_rcpf(1.0f + __expf(-x)); }
#define MFMA16(a, b, c) __builtin_amdgcn_mfma_f32_16x16x32_bf16((a), (b), (c), 0, 0, 0)
#define LDS_FENCE() asm volatile("s_waitcnt lgkmcnt(0)" ::: "memory")

__device__ __forceinline__ void transpose_item(const float* W, int K, int N, bf16* WT, int k0, int sc0, int dr0, LAS float* scr, int lane) {
#pragma unroll 8
    for (int i = 0; i < 32; ++i) { const int kk = 2 * i + (lane >> 5); scr[kk * 33 + (lane & 31)] = W[(size_t)(k0 + kk) * N + sc0 + (lane & 31)]; }
    LDS_WAIT(); asm volatile("" ::: "memory");
    const int c = lane & 7;
#pragma unroll
    for (int j = 0; j < 4; ++j) { const int n = (lane >> 3) + 8 * j; const LAS float* s = scr + (8 * c) * 33 + n;
        v4u o; o.x = pk2(s[0 * 33], s[1 * 33]); o.y = pk2(s[2 * 33], s[3 * 33]); o.z = pk2(s[4 * 33], s[5 * 33]); o.w = pk2(s[6 * 33], s[7 * 33]);
        *(GAS v4u*)(WT + (size_t)(dr0 + n) * K + k0 + 8 * c) = o; }
    LDS_WAIT(); asm volatile("" ::: "memory");
}
__device__ __forceinline__ void conv_up(const Frame& F, const float* W, bf16* WT, LAS float* scr, int it) {
    const int kb = it / 176, nb = it % 176, sc0 = nb * 32;
    const int j = sc0 < FF ? sc0 : sc0 - FF; const int dr0 = 256 * (j >> 7) + (sc0 < FF ? 0 : 128) + (j & 127);
    transpose_item(W, DM, NUP, WT, kb * 64, sc0, dr0, scr, F.lane);
}
__device__ __forceinline__ void conv_plain(const Frame& F, const float* W, int K, int N, int ncols, int scoff, bf16* WT, LAS float* scr, int it) {
    const int nblk = ncols / 32, kb = it / nblk, nb = it % nblk;
    transpose_item(W, K, N, WT, kb * 64, scoff + nb * 32, nb * 32, scr, F.lane);
}
__device__ __forceinline__ void convert_ffn_weights(const Frame& F, const float* wup, const float* wdown, int scr_base, int it_lo, int it_hi, int rank, int nrank) {
    LAS float* scr = (LAS float*)(F.lds + scr_base + F.wave * 8448);
    bf16* wb = (bf16*)(F.ws + WS_W);
    const int gw = rank * NWAVES + F.wave, NGW = nrank * NWAVES;
    constexpr int I_UP = 16 * 176;
    for (int it = it_lo + gw; it < it_hi; it += NGW) {
        if (it < I_UP) conv_up(F, wup, wb + W_UP / 2, scr, it);
        else conv_plain(F, wdown, FF, DM, DM, 0, wb + W_DOWN / 2, scr, it - I_UP);
    }
}
__device__ __forceinline__ void convert_mix_weights(const Frame& F, const float* w_in, const float* w_a, const float* w_b, const float* w_o, int scr_base, int it_lo, int it_hi, int rank, int nrank) {
    LAS float* scr = (LAS float*)(F.lds + scr_base + F.wave * 8448);
    bf16* wb = (bf16*)(F.ws + WS_W);
    const int gw = rank * NWAVES + F.wave, NGW = nrank * NWAVES;
    constexpr int I1 = 16 * 88, I2 = 16 * 64, I3 = 8 * 32;
    for (int it = it_lo + gw; it < it_hi; it += NGW) {
        int r = it;
        if (r < I1) { conv_plain(F, w_in, DM, INDIM, NZ1, 0, wb + W_IN1 / 2, scr, r); continue; } r -= I1;
        if (r < I2) { conv_plain(F, w_in, DM, INDIM, NGATE, 2824, wb + W_G / 2, scr, r); continue; } r -= I2;
        if (r < I3) { conv_plain(F, w_a, 512, DM, DM, 0, wb + W_A / 2, scr, r); continue; } r -= I3;
        if (r < I3) { conv_plain(F, w_b, 512, DM, DM, 0, wb + W_B / 2, scr, r); continue; } r -= I3;
        conv_plain(F, w_o, DM, DM, DM, 0, wb + W_O / 2, scr, r);
    }
}

template <int MODE, int NSPLIT> __device__ __forceinline__ void rowwise(const Frame& F, const float* wpost, const float* wpre, const float* xp, const float* xs, const float* a_log, const float* dt_bias) {
    const int gw = F.vcu * NWAVES + F.wave, NGW = F.G * NWAVES, lane = F.lane;
#define RW_COL(j) (8 * lane + 512 * ((j) >> 1) + 4 * ((j) & 1))
    float* Y = F.out + O_Y; const float* MBp = (const float*)(F.ws + WS_RB); bf16* XN = (bf16*)(F.ws + WS_XN);
    f32x4 wq[4], wp[4];
#pragma unroll
    for (int j = 0; j < 4; ++j) { if (MODE != 0) wq[j] = *(const f32x4*)(wpost + RW_COL(j)); if (MODE != 3) wp[j] = *(const f32x4*)(wpre + RW_COL(j)); }
    const LAS float* wab = (const LAS float*)F.lds;
    float alog = 0.f, dtb = 0.f;
    if (MODE == 1) { alog = __expf(a_log[lane & 3]); dtb = dt_bias[lane & 3]; }
    for (int m = gw; m < MROWS; m += NGW) {
        f32x4 x[4];
        if (MODE == 0 || MODE == 1) { const float* xr = (m < MP) ? xp + (size_t)m * DM : xs + (size_t)(m - MP) * DM;
#pragma unroll
            for (int j = 0; j < 4; ++j) x[j] = *(const f32x4*)(xr + RW_COL(j));
        } else {
#pragma unroll
            for (int j = 0; j < 4; ++j) x[j] = *(const f32x4*)(Y + (size_t)m * DM + RW_COL(j));
        }
        if (MODE != 0) {
            f32x4 mb[4]; float s = 0.f;
#pragma unroll
            for (int p = 0; p < 2; ++p) {
                if (m < MP) { const v4u mw = *(const v4u*)((const bf16*)MBp + (size_t)m * DM + 8 * lane + 512 * p);
                    mb[2 * p] = (f32x4){blo(mw.x), bhi(mw.x), blo(mw.y), bhi(mw.y)}; mb[2 * p + 1] = (f32x4){blo(mw.z), bhi(mw.z), blo(mw.w), bhi(mw.w)}; }
                else {
#pragma unroll
                    for (int q = 0; q < 2; ++q) { const int j = 2 * p + q; const float* pp = (const float*)(F.ws + WS_RC) + (size_t)(m - MP) * DM + RW_COL(j); mb[j] = *(const f32x4*)pp;
#pragma unroll
                        for (int sp = 1; sp < NSPLIT; ++sp) mb[j] += *(const f32x4*)(pp + (size_t)sp * MS * DM); } }
            }
#pragma unroll
            for (int j = 0; j < 4; ++j) s += (mb[j].x * mb[j].x + mb[j].y * mb[j].y) + (mb[j].z * mb[j].z + mb[j].w * mb[j].w);
            const float r = rsqrtf(wave_sum(s) * (1.f / DM) + EPS) * (MODE == 2 ? 1.0f : 0.5f);
#pragma unroll
            for (int j = 0; j < 4; ++j) { x[j] = x[j] + mb[j] * r * wq[j]; *(f32x4*)(Y + (size_t)m * DM + RW_COL(j)) = x[j]; }
        }
        if (MODE != 3) {
            float s = 0.f;
#pragma unroll
            for (int j = 0; j < 4; ++j) s += (x[j].x * x[j].x + x[j].y * x[j].y) + (x[j].z * x[j].z + x[j].w * x[j].w);
            const float r = rsqrtf(wave_sum(s) * (1.f / DM) + EPS);
            f32x4 h[4];
#pragma unroll
            for (int j = 0; j < 4; ++j) h[j] = x[j] * r * wp[j];
#pragma unroll
            for (int p = 0; p < 2; ++p) { v4u o; o.x = pk2(h[2 * p].x, h[2 * p].y); o.y = pk2(h[2 * p].z, h[2 * p].w); o.z = pk2(h[2 * p + 1].x, h[2 * p + 1].y); o.w = pk2(h[2 * p + 1].z, h[2 * p + 1].w);
                *(v4u*)(XN + (size_t)m * DM + 8 * lane + 512 * p) = o; }
            if (MODE == 1) {
                float d[8];
#pragma unroll
                for (int c = 0; c < 8; ++c) d[c] = 0.f;
#pragma unroll
                for (int j = 0; j < 4; ++j)
#pragma unroll
                    for (int e = 0; e < 4; ++e) { const int sl = ((e * 4 + j) * 64 + lane) * 8; const f32x4 w0 = *(const LAS f32x4*)(wab + sl), w1 = *(const LAS f32x4*)(wab + sl + 4); const float hv = h[j][e];
                        d[0] += hv * w0.x; d[1] += hv * w0.y; d[2] += hv * w0.z; d[3] += hv * w0.w; d[4] += hv * w1.x; d[5] += hv * w1.y; d[6] += hv * w1.z; d[7] += hv * w1.w; }
#pragma unroll
                for (int c = 0; c < 8; ++c) d[c] = wave_sum(d[c]);
                float mine = d[0];
#pragma unroll
                for (int c = 1; c < 8; ++c) mine = (lane == c) ? d[c] : mine;
                if (lane < 8) { float v;
                    if (lane < 4) { const float a = mine + dtb; const float sp = fmaxf(a, 0.f) + log1pf(__expf(-fabsf(a))); v = -alog * sp; }
                    else v = sigmf(mine);
                    ((float*)(F.ws + WS_GB))[(size_t)m * 8 + lane] = v; }
            }
        }
    }
}
#undef RW_COL

template <bool SAMPLE> __device__ __forceinline__ void attn_unit(const Frame& F, const float* cache_k, const float* cache_v, const float* sinks, int b, int kvh, int qb) {
    constexpr int NK = SAMPLE ? 160 : 192, NT = NK / 16, NKS = NK / 32;
    LAS bf16* Ks = (LAS bf16*)(F.lds); LAS bf16* Vt = (LAS bf16*)(F.lds + 27648); LAS bf16* Pw = (LAS bf16*)(F.lds + 53248 + F.wave * 6400);
    const bf16* ZA = (const bf16*)(F.ws + WS_RA + RA_ZA); bf16* OA = (bf16*)(F.ws + WS_RC);
    const int kstart = SAMPLE ? 0 : qb * 64 - 128;
    for (int p = F.tid; p < NK * 8; p += 512) {
        const int kk = p >> 3, part = p & 7;
        v4u kv = {0u, 0u, 0u, 0u}, vv = {0u, 0u, 0u, 0u};
        if (SAMPLE) {
            if (kk < 128) { const size_t o = (((size_t)b * 128 + kk) * 2 + kvh) * 64 + part * 8;
                const f32x4 k0 = *(const f32x4*)(cache_k + o), k1 = *(const f32x4*)(cache_k + o + 4), v0 = *(const f32x4*)(cache_v + o), v1 = *(const f32x4*)(cache_v + o + 4);
                kv.x = pk2(k0.x, k0.y); kv.y = pk2(k0.z, k0.w); kv.z = pk2(k1.x, k1.y); kv.w = pk2(k1.z, k1.w);
                vv.x = pk2(v0.x, v0.y); vv.y = pk2(v0.z, v0.w); vv.z = pk2(v1.x, v1.y); vv.w = pk2(v1.z, v1.w);
            } else if (kk < 136) { const size_t row = (size_t)MP + b * 8 + (kk - 128);
                kv = *(const v4u*)(ZA + row * 768 + 512 + kvh * 64 + part * 8); vv = *(const v4u*)(ZA + row * 768 + 640 + kvh * 64 + part * 8); }
        } else {
            const int tok = kstart + kk;
            if (tok >= 0) { const size_t row = (size_t)b * SEQ + tok;
                kv = *(const v4u*)(ZA + row * 768 + 512 + kvh * 64 + part * 8); vv = *(const v4u*)(ZA + row * 768 + 640 + kvh * 64 + part * 8); }
        }
        *(LAS v4u*)(Ks + kk * 72 + part * 8) = kv;
        const unsigned vw[4] = {vv.x, vv.y, vv.z, vv.w};
#pragma unroll
        for (int i = 0; i < 4; ++i) { Vt[(part * 8 + 2 * i) * 200 + kk] = (bf16)(vw[i] & 0xffffu); Vt[(part * 8 + 2 * i + 1) * 200 + kk] = (bf16)(vw[i] >> 16); }
    }
    __syncthreads();
    const int fr = F.lane & 15, fq = F.lane >> 4;
    if (F.wave < (SAMPLE ? 2 : 8)) {
#pragma unroll 1
        for (int mt = 0; mt < (SAMPLE ? 1 : 2); ++mt) {
            int qi, head; size_t row;
            if (SAMPLE) { const int r = 16 * F.wave + fr; head = kvh * 4 + (r >> 3); qi = r & 7; row = (size_t)MP + b * 8 + qi; }
            else { head = kvh * 4 + (F.wave >> 1); qi = 32 * (F.wave & 1) + 16 * mt + fr; row = (size_t)b * SEQ + qb * 64 + qi; }
            bf16x8 qf[2];
#pragma unroll
            for (int ks = 0; ks < 2; ++ks) qf[ks] = *(const bf16x8*)(ZA + row * 768 + head * 64 + 32 * ks + 8 * fq);
            f32x4 s[NT];
#pragma unroll
            for (int nt = 0; nt < NT; ++nt) { s[nt] = (f32x4){0.f, 0.f, 0.f, 0.f};
#pragma unroll
                for (int ks = 0; ks < 2; ++ks) { const bf16x8 kf = *(const LAS bf16x8*)(Ks + (16 * nt + fr) * 72 + 32 * ks + 8 * fq); s[nt] = MFMA16(kf, qf[ks], s[nt]); } }
            float mx = -1e30f;
#pragma unroll
            for (int nt = 0; nt < NT; ++nt)
#pragma unroll
                for (int j = 0; j < 4; ++j) { const int kk = 16 * nt + 4 * fq + j; const bool valid = (kk > qi) && (kk <= 128 + qi) && (SAMPLE || kstart + kk >= 0);
                    const float v = valid ? s[nt][j] * 0.125f : -1e30f; s[nt][j] = v; mx = fmaxf(mx, v); }
            mx = fmaxf(mx, __shfl_xor(mx, 16)); mx = fmaxf(mx, __shfl_xor(mx, 32));
            const float sink = sinks[head]; mx = fmaxf(mx, sink);
            float sum = 0.f;
#pragma unroll
            for (int nt = 0; nt < NT; ++nt) {
#pragma unroll
                for (int j = 0; j < 4; ++j) { const float p = __expf(s[nt][j] - mx); s[nt][j] = p; sum += p; }
                v2u w; w.x = pk2(s[nt][0], s[nt][1]); w.y = pk2(s[nt][2], s[nt][3]); *(LAS v2u*)(Pw + fr * 200 + 16 * nt + 4 * fq) = w; }
            sum += __shfl_xor(sum, 16); sum += __shfl_xor(sum, 32);
            const float inv = 1.0f / (sum + __expf(sink - mx));
            LDS_FENCE();
            f32x4 o[4];
#pragma unroll
            for (int nd = 0; nd < 4; ++nd) o[nd] = (f32x4){0.f, 0.f, 0.f, 0.f};
#pragma unroll
            for (int ks = 0; ks < NKS; ++ks) { const bf16x8 pf = *(const LAS bf16x8*)(Pw + fr * 200 + 32 * ks + 8 * fq);
#pragma unroll
                for (int nd = 0; nd < 4; ++nd) { const bf16x8 vf = *(const LAS bf16x8*)(Vt + (16 * nd + fr) * 200 + 32 * ks + 8 * fq); o[nd] = MFMA16(vf, pf, o[nd]); } }
#pragma unroll
            for (int nd = 0; nd < 4; ++nd) { v2u w; w.x = pk2(o[nd][0] * inv, o[nd][1] * inv); w.y = pk2(o[nd][2] * inv, o[nd][3] * inv);
                *(v2u*)(OA + row * 512 + head * 64 + 16 * nd + 4 * fq) = w; }
            LDS_FENCE();
        }
    }
    __syncthreads();
}

__device__ __forceinline__ void prep_pair(const Frame& F, const float* conv_w, int pair) {
    const int hb = F.tid >> 8, t = F.tid & 255, hw = F.wave & 3, lane = F.lane, fr = lane & 15, fq = lane >> 4;
    const int uid = 2 * pair + hb, b = uid >> 7, h = (uid >> 5) & 3, ch = uid & 31;
    LAS unsigned char* L = F.lds + hb * PREP_HALF;
    LAS bf16* Xq = (LAS bf16*)L; LAS bf16* Xk = Xq + 64 * 136; LAS bf16* Xv = Xk + 64 * 136;
    LAS float* Mf = (LAS float*)(L + 52224); LAS float* sc = (LAS float*)(L + 52224 + 16384);
    const bf16* ZC = (const bf16*)(F.ws + WS_RA + RA_ZC); const float* GB = (const float*)(F.ws + WS_GB);
    unsigned char* PU = F.ws + WS_RB + (size_t)uid * PREP_UNIT;
    const size_t row0 = (size_t)b * SEQ + ch * 64;
    if (hw == 0) {
        const float g = GB[(row0 + lane) * 8 + h], bt = GB[(row0 + lane) * 8 + 4 + h];
        float c = g;
#pragma unroll
        for (int o = 1; o < 64; o <<= 1) { const float n = __shfl_up(c, o); if (lane >= o) c += n; }
        sc[lane] = c; sc[64 + lane] = bt; sc[128 + lane] = __expf(c);
    }
    {
        const int co = t & 15, tg = t >> 4, trel = ch * 64 + 4 * tg - 3;
        v4u raw[3][7];
#pragma unroll
        for (int grp = 0; grp < 3; ++grp)
#pragma unroll
            for (int k = 0; k < 7; ++k) { const v4u z = {0u, 0u, 0u, 0u};
                raw[grp][k] = (trel + k >= 0) ? *(const v4u*)(ZC + (row0 + 4 * tg - 3 + k) * CONVD + grp * 512 + h * 128 + 8 * co) : z; }
#pragma unroll
        for (int grp = 0; grp < 3; ++grp) { const float* wp = conv_w + grp * 512 + h * 128 + 8 * co;
            f32x4 wv[4][2];
#pragma unroll
            for (int j = 0; j < 4; ++j) { wv[j][0] = *(const f32x4*)(wp + j * CONVD); wv[j][1] = *(const f32x4*)(wp + j * CONVD + 4); }
            LAS bf16* X = grp == 0 ? Xq : (grp == 1 ? Xk : Xv);
#pragma unroll
            for (int i = 0; i < 4; ++i) { float o[8];
#pragma unroll
                for (int e = 0; e < 8; ++e) o[e] = 0.f;
#pragma unroll
                for (int j = 0; j < 4; ++j) { const v4u r = raw[grp][i + j]; const float xv[8] = {blo(r.x), bhi(r.x), blo(r.y), bhi(r.y), blo(r.z), bhi(r.z), blo(r.w), bhi(r.w)};
#pragma unroll
                    for (int e = 0; e < 8; ++e) o[e] += wv[j][e >> 2][e & 3] * xv[e]; }
                v4u pk; pk.x = pk2(siluf(o[0]), siluf(o[1])); pk.y = pk2(siluf(o[2]), siluf(o[3])); pk.z = pk2(siluf(o[4]), siluf(o[5])); pk.w = pk2(siluf(o[6]), siluf(o[7]));
                *(LAS v4u*)(X + (4 * tg + i) * 136 + 8 * co) = pk; }
        }
    }
    __syncthreads();
    if (t < 128) { const int grp = t >> 6, i = t & 63; const LAS bf16* X = (grp == 0 ? Xq : Xk) + i * 136; float ss = 0.f;
#pragma unroll
        for (int k = 0; k < 16; ++k) { const v4u w = *(const LAS v4u*)(X + 8 * k); const float a0 = blo(w.x), a1 = bhi(w.x), a2 = blo(w.y), a3 = bhi(w.y), a4 = blo(w.z), a5 = bhi(w.z), a6 = blo(w.w), a7 = bhi(w.w);
            ss += (a0 * a0 + a1 * a1) + (a2 * a2 + a3 * a3) + (a4 * a4 + a5 * a5) + (a6 * a6 + a7 * a7); }
        sc[192 + grp * 64 + i] = rsqrtf(ss + EPS); }
    __syncthreads();
    {
        const int i = 16 * hw + fr;
        f32x4 kk[4], qk[4];
#pragma unroll
        for (int nt = 0; nt < 4; ++nt) { kk[nt] = (f32x4){0.f, 0.f, 0.f, 0.f}; qk[nt] = (f32x4){0.f, 0.f, 0.f, 0.f}; }
#pragma unroll
        for (int ks = 0; ks < 4; ++ks) { const bf16x8 ak = *(const LAS bf16x8*)(Xk + i * 136 + 32 * ks + 8 * fq), aq = *(const LAS bf16x8*)(Xq + i * 136 + 32 * ks + 8 * fq);
#pragma unroll
            for (int nt = 0; nt < 4; ++nt) { const bf16x8 bk = *(const LAS bf16x8*)(Xk + (16 * nt + fr) * 136 + 32 * ks + 8 * fq); kk[nt] = MFMA16(bk, ak, kk[nt]); qk[nt] = MFMA16(bk, aq, qk[nt]); } }
        const float gi = sc[i], bi = sc[64 + i], rki = sc[256 + i], rqi = sc[192 + i] * 0.08838834764831845f;
        bf16* QKg = (bf16*)(PU + PU_QK);
#pragma unroll
        for (int nt = 0; nt < 4; ++nt) { f32x4 mv, qv;
#pragma unroll
            for (int jj = 0; jj < 4; ++jj) { const int j = 16 * nt + 4 * fq + jj; const float gj = sc[j], rkj = sc[256 + j];
                const float dec = (i >= j) ? __expf(gi - gj) : 0.f;
                mv[jj] = (i > j) ? kk[nt][jj] * rki * rkj * bi * dec : 0.f; qv[jj] = (i >= j) ? qk[nt][jj] * rqi * rkj * dec : 0.f; }
            *(LAS f32x4*)(Mf + i * 64 + 16 * nt + 4 * fq) = mv;
            v2u w; w.x = pk2(qv[0], qv[1]); w.y = pk2(qv[2], qv[3]); *(v2u*)(QKg + i * 64 + 16 * nt + 4 * fq) = w; }
    }
    __syncthreads();
    {
        float x[64];
        if (t < 128) {
#pragma unroll
            for (int i = 0; i < 64; ++i) x[i] = bf2f(Xk[i * 136 + t]) * (sc[256 + i] * sc[64 + i] * sc[128 + i]);
        } else {
#pragma unroll
            for (int i = 0; i < 64; ++i) x[i] = bf2f(Xv[i * 136 + (t - 128)]) * sc[64 + i];
        }
#pragma unroll
        for (int bb = 0; bb < 4; ++bb) {
#pragma unroll
            for (int j4 = 0; j4 < 16 * bb; j4 += 4) { f32x4 m[16];
#pragma unroll
                for (int r = 0; r < 16; ++r) m[r] = *(const LAS f32x4*)(Mf + (16 * bb + r) * 64 + j4);
                __builtin_amdgcn_sched_barrier(0);
#pragma unroll
                for (int r = 0; r < 16; ++r) { float a = x[16 * bb + r]; a = __builtin_fmaf(-m[r][0], x[j4], a); a = __builtin_fmaf(-m[r][1], x[j4 + 1], a); a = __builtin_fmaf(-m[r][2], x[j4 + 2], a); a = __builtin_fmaf(-m[r][3], x[j4 + 3], a); x[16 * bb + r] = a; }
                __builtin_amdgcn_sched_barrier(0); }
#pragma unroll
            for (int r = 1; r < 16; ++r) { f32x4 m[4];
#pragma unroll
                for (int q = 0; q <= (r - 1) / 4; ++q) m[q] = *(const LAS f32x4*)(Mf + (16 * bb + r) * 64 + 16 * bb + 4 * q);
                float a = x[16 * bb + r];
#pragma unroll
                for (int j = 0; j < r; ++j) a -= m[j >> 2][j & 3] * x[16 * bb + j];
                x[16 * bb + r] = a; }
        }
        if (t < 128) { bf16* KC = (bf16*)(PU + PU_KC);
#pragma unroll
            for (int i = 0; i < 64; ++i) KC[i * 128 + t] = (bf16)f2bf(x[i]);
        } else { bf16* VU = (bf16*)(PU + PU_VU) + (t - 128) * 64;
#pragma unroll
            for (int k = 0; k < 8; ++k) { v4u w; w.x = pk2(x[8 * k], x[8 * k + 1]); w.y = pk2(x[8 * k + 2], x[8 * k + 3]); w.z = pk2(x[8 * k + 4], x[8 * k + 5]); w.w = pk2(x[8 * k + 6], x[8 * k + 7]); *(v4u*)(VU + 8 * k) = w; }
        }
    }
    {
        const int i = t >> 2, d0 = (t & 3) * 32; const float sq = sc[192 + i] * 0.08838834764831845f * sc[128 + i];
        bf16* QD = (bf16*)(PU + PU_QD) + i * 128 + d0;
#pragma unroll
        for (int k = 0; k < 4; ++k) { const v4u w = *(const LAS v4u*)(Xq + i * 136 + d0 + 8 * k); v4u o;
            o.x = pk2(blo(w.x) * sq, bhi(w.x) * sq); o.y = pk2(blo(w.y) * sq, bhi(w.y) * sq); o.z = pk2(blo(w.z) * sq, bhi(w.z) * sq); o.w = pk2(blo(w.w) * sq, bhi(w.w) * sq); *(v4u*)(QD + 8 * k) = o; }
        const int d = t >> 1, c0 = (t & 1) * 32; const float gl = sc[63];
        bf16* KD = (bf16*)(PU + PU_KD) + d * 64 + c0;
#pragma unroll
        for (int k = 0; k < 4; ++k) { float v[8];
#pragma unroll
            for (int e = 0; e < 8; ++e) { const int c = c0 + 8 * k + e; v[e] = bf2f(Xk[c * 136 + d]) * sc[256 + c] * __expf(gl - sc[c]); }
            v4u o; o.x = pk2(v[0], v[1]); o.y = pk2(v[2], v[3]); o.z = pk2(v[4], v[5]); o.w = pk2(v[6], v[7]); *(v4u*)(KD + 8 * k) = o; }
        if (t == 0) ((float*)(F.ws + WS_GT))[uid] = sc[128 + 63];
    }
    __syncthreads();
}

struct ScanOps { bf16x8 kd[2], kc[4], qd[4], qkf[2]; v2u vu; float gt; };
__device__ __forceinline__ void scan_load(ScanOps& o, const unsigned char* PU, const float* GT, int idx, int w, int es, int fr, int fq) {
    o.gt = GT[idx];
#pragma unroll
    for (int ks = 0; ks < 2; ++ks) o.kd[ks] = *(const bf16x8*)((const bf16*)(PU + PU_KD) + (16 * w + fr) * 64 + 32 * ks + 8 * fq);
    if (w < 4) {
#pragma unroll
        for (int ks = 0; ks < 4; ++ks) { o.kc[ks] = *(const bf16x8*)((const bf16*)(PU + PU_KC) + (16 * w + fr) * 128 + 32 * ks + 8 * fq); o.qd[ks] = *(const bf16x8*)((const bf16*)(PU + PU_QD) + (16 * w + fr) * 128 + 32 * ks + 8 * fq); }
#pragma unroll
        for (int ks = 0; ks < 2; ++ks) o.qkf[ks] = *(const bf16x8*)((const bf16*)(PU + PU_QK) + (16 * w + fr) * 64 + 32 * ks + 8 * fq);
        o.vu = *(const v2u*)((const bf16*)(PU + PU_VU) + (16 * es + fr) * 64 + 16 * w + 4 * fq);
    }
}
#define LDS_BAR() asm volatile("s_waitcnt lgkmcnt(0)\n\ts_barrier" ::: "memory")
#define SCAN_STEP(CUR, NXT, n_) do { const int n__ = (n_); const int nn = n__ < 31 ? n__ + 1 : 31; \
        scan_load(NXT, PU0 + (size_t)nn * PREP_UNIT, GT, bh * 32 + nn, w, es, fr, fq); \
        f32x4 O = {0.f, 0.f, 0.f, 0.f}; \
        if (w < 4) { f32x4 X = {0.f, 0.f, 0.f, 0.f}; \
            _Pragma("unroll") for (int ks = 0; ks < 4; ++ks) { const bf16x8 sf = *(const LAS bf16x8*)(Ss + fr * 136 + 32 * ks + 8 * fq); X = MFMA16(CUR.kc[ks], sf, X); O = MFMA16(CUR.qd[ks], sf, O); } \
            v2u o; o.x = pk2(blo(CUR.vu.x) - X[0], bhi(CUR.vu.x) - X[1]); o.y = pk2(blo(CUR.vu.y) - X[2], bhi(CUR.vu.y) - X[3]); \
            *(LAS v2u*)(Vn + fr * 72 + 16 * w + 4 * fq) = o; } \
        LDS_BAR(); \
        bf16x8 vf[2]; \
        _Pragma("unroll") for (int ks = 0; ks < 2; ++ks) vf[ks] = *(const LAS bf16x8*)(Vn + fr * 72 + 32 * ks + 8 * fq); \
        if (w < 4) { \
            _Pragma("unroll") for (int ks = 0; ks < 2; ++ks) O = MFMA16(CUR.qkf[ks], vf[ks], O); \
            const size_t row = (size_t)b * SEQ + 64 * n__ + 16 * w + 4 * fq; \
            _Pragma("unroll") for (int j = 0; j < 4; ++j) OBR[(row + j) * 512 + h * 128 + 16 * es + fr] = O[j]; } \
        S = S * CUR.gt; \
        _Pragma("unroll") for (int ks = 0; ks < 2; ++ks) S = MFMA16(CUR.kd[ks], vf[ks], S); \
        { v2u o; o.x = pk2(S[0], S[1]); o.y = pk2(S[2], S[3]); *(LAS v2u*)(Ss + fr * 136 + 16 * w + 4 * fq) = o; } \
        LDS_BAR(); } while (0)
__device__ __forceinline__ void scan_unit(const Frame& F, int unit) {
    const int bh = unit >> 3, es = unit & 7, b = bh >> 2, h = bh & 3, w = F.wave, lane = F.lane, fr = lane & 15, fq = lane >> 4;
    LAS bf16* Ss = (LAS bf16*)F.lds; LAS bf16* Vn = (LAS bf16*)(F.lds + 4352);
    for (int p = F.tid; p < (4352 + 2304) / 4; p += 512) ((LAS unsigned*)F.lds)[p] = 0u;
    float* OBR = (float*)(F.ws + WS_RA + RA_ZC);
    const unsigned char* PU0 = F.ws + WS_RB + (size_t)(bh * 32) * PREP_UNIT; const float* GT = (const float*)(F.ws + WS_GT);
    f32x4 S = {0.f, 0.f, 0.f, 0.f};
    ScanOps opA, opB;
    scan_load(opA, PU0, GT, bh * 32, w, es, fr, fq);
    __syncthreads();
#pragma unroll 1
    for (int n = 0; n < 32; n += 2) { SCAN_STEP(opA, opB, n); SCAN_STEP(opB, opA, n + 1); }
    float* DP = F.out + O_DP + (size_t)bh * 128 * 128;
#pragma unroll
    for (int j = 0; j < 4; ++j) DP[(16 * w + 4 * fq + j) * 128 + 16 * es + fr] = S[j];
    __syncthreads();
}

__device__ __forceinline__ void dn_sample_unit(const Frame& F, const float* state_conv, const float* state_delta, const float* conv_w, const float* out_norm, int unit) {
    const int b = unit >> 2, h = unit & 3, tid = F.tid, e = tid & 127, dq = tid >> 7, lane = F.lane, w = F.wave;
    LAS float* X = (LAS float*)F.lds;
    LAS float* scl = (LAS float*)(F.lds + 12288);
    LAS float* pA = (LAS float*)(F.lds + 12544);
    LAS float* pB = (LAS float*)(F.lds + 14592);
    LAS float* osm = (LAS float*)(F.lds + 16640);
    const bf16* ZC = (const bf16*)(F.ws + WS_RA + RA_ZC); const bf16* ZZ = (const bf16*)(F.ws + WS_RA + RA_ZZ); const float* GB = (const float*)(F.ws + WS_GB);
    bf16* OB = (bf16*)(F.ws + WS_RC) + (size_t)MROWS * 512;
    const size_t row0 = (size_t)MP + b * 8;
#pragma unroll
    for (int r = 0; r < 6; ++r) { const int idx = tid + 512 * r, grp = idx >> 10, i = (idx >> 7) & 7, c = idx & 127, chn = grp * 512 + h * 128 + c;
        float acc = 0.f;
#pragma unroll
        for (int j = 0; j < 4; ++j) { const int tt = i - 3 + j; const float xv = tt < 0 ? state_conv[((size_t)b * 3 + (3 + tt)) * CONVD + chn] : bf2f(ZC[(row0 + tt) * CONVD + chn]); acc += conv_w[j * CONVD + chn] * xv; }
        X[idx] = siluf(acc); }
    if (tid < 8) { scl[16 + tid] = GB[(row0 + tid) * 8 + h]; scl[24 + tid] = GB[(row0 + tid) * 8 + 4 + h]; }
    __syncthreads();
    { const float q0 = X[w * 128 + lane], q1 = X[w * 128 + lane + 64], k0 = X[1024 + w * 128 + lane], k1 = X[1024 + w * 128 + lane + 64];
      const float sq = wave_sum(q0 * q0 + q1 * q1), sk = wave_sum(k0 * k0 + k1 * k1);
      if (lane == 0) { scl[w] = rsqrtf(sq + EPS) * 0.08838834764831845f; scl[8 + w] = rsqrtf(sk + EPS); } }
    float s[32];
    const float* S0 = state_delta + ((size_t)unit * 128 + 32 * dq) * 128 + e;
#pragma unroll
    for (int r = 0; r < 32; ++r) s[r] = S0[(size_t)r * 128];
    __syncthreads();
#pragma unroll 1
    for (int i = 0; i < 8; ++i) {
        const float eg = __expf(scl[16 + i]), bt = scl[24 + i], rk = scl[8 + i], rq = scl[i];
        const LAS float* kr = X + 1024 + i * 128 + 32 * dq; const LAS float* qr = X + i * 128 + 32 * dq;
        float p = 0.f;
#pragma unroll
        for (int r = 0; r < 32; ++r) { s[r] *= eg; p += kr[r] * s[r]; }
        pA[dq * 128 + e] = p * rk;
        __syncthreads();
        const float kS = (pA[e] + pA[128 + e]) + (pA[256 + e] + pA[384 + e]);
        const float u = bt * (X[2048 + i * 128 + e] - kS) * rk;
        float p2 = 0.f;
#pragma unroll
        for (int r = 0; r < 32; ++r) { s[r] += kr[r] * u; p2 += qr[r] * s[r]; }
        pB[dq * 128 + e] = p2 * rq;
        __syncthreads();
        if (dq == 0) osm[i * 128 + e] = (pB[e] + pB[128 + e]) + (pB[256 + e] + pB[384 + e]);
    }
    __syncthreads();
    {
        const float o0 = osm[w * 128 + lane], o1 = osm[w * 128 + lane + 64];
        const float r = rsqrtf(wave_sum(o0 * o0 + o1 * o1) * (1.f / 128.f) + EPS);
        const size_t row = row0 + w;
        const float z0 = bf2f(ZZ[row * 512 + h * 128 + lane]), z1 = bf2f(ZZ[row * 512 + h * 128 + lane + 64]);
        OB[row * 512 + h * 128 + lane] = (bf16)f2bf(o0 * r * out_norm[lane] * siluf(z0));
        OB[row * 512 + h * 128 + lane + 64] = (bf16)f2bf(o1 * r * out_norm[lane + 64] * siluf(z1));
    }
    float* DSo = F.out + O_DS + ((size_t)unit * 128 + 32 * dq) * 128 + e;
#pragma unroll
    for (int r = 0; r < 32; ++r) DSo[(size_t)r * 128] = s[r];
    __syncthreads();
}


__device__ __forceinline__ void gated_norm_prompt(const Frame& F, const float* out_norm) {
    const int nbusy = (544 - 2 * F.G > 0 && 544 - 2 * F.G < F.G) ? 544 - 2 * F.G : 0;
    if ((int)blockIdx.x < nbusy) return;
    const int gw = ((int)blockIdx.x - nbusy) * NWAVES + F.wave, NGW = (F.G - nbusy) * NWAVES, lane = F.lane, head = lane >> 4, e0 = (lane & 15) * 8;
    const float* OBR = (const float*)(F.ws + WS_RA + RA_ZC); const bf16* ZZ = (const bf16*)(F.ws + WS_RA + RA_ZZ); bf16* OB = (bf16*)(F.ws + WS_RC) + (size_t)MROWS * 512;
    const f32x4 w0 = *(const f32x4*)(out_norm + e0), w1 = *(const f32x4*)(out_norm + e0 + 4);
    for (int m = gw; m < MP; m += NGW) {
        const size_t o = (size_t)m * 512 + head * 128 + e0;
        const f32x4 a = *(const f32x4*)(OBR + o), c = *(const f32x4*)(OBR + o + 4); const v4u z = *(const v4u*)(ZZ + o);
        float ss = (a.x * a.x + a.y * a.y) + (a.z * a.z + a.w * a.w) + (c.x * c.x + c.y * c.y) + (c.z * c.z + c.w * c.w);
        ss += __shfl_xor(ss, 1); ss += __shfl_xor(ss, 2); ss += __shfl_xor(ss, 4); ss += __shfl_xor(ss, 8);
        const float r = rsqrtf(ss * (1.f / 128.f) + EPS);
        v4u ov; ov.x = pk2(a.x * r * w0.x * siluf(blo(z.x)), a.y * r * w0.y * siluf(bhi(z.x))); ov.y = pk2(a.z * r * w0.z * siluf(blo(z.y)), a.w * r * w0.w * siluf(bhi(z.y)));
        ov.z = pk2(c.x * r * w1.x * siluf(blo(z.z)), c.y * r * w1.y * siluf(bhi(z.z))); ov.w = pk2(c.z * r * w1.z * siluf(blo(z.w)), c.w * r * w1.w * siluf(bhi(z.w)));
        *(v4u*)(OB + o) = ov;
    }
}

__device__ __forceinline__ void store8_bf(float* dst, v4u w) {
    *(f32x4*)dst = (f32x4){blo(w.x), bhi(w.x), blo(w.y), bhi(w.y)}; *(f32x4*)(dst + 4) = (f32x4){blo(w.z), bhi(w.z), blo(w.w), bhi(w.w)};
}
template <int PART> __device__ __forceinline__ void copy_outputs(const Frame& F, const float* cache_k, const float* cache_v, int rank, int nrank) {
    const bf16* ZA = (const bf16*)(F.ws + WS_RA + RA_ZA); const bf16* ZC = (const bf16*)(F.ws + WS_RA + RA_ZC);
    int t_ = F.wave * 64 + hw_lane(); asm volatile("" : "+v"(t_));
    const int gt = rank * 512 + t_, GS = nrank * 512;
    if (PART == 0) {
    for (int g = gt; g < 32768; g += GS) { const int which = g >> 14, rem8 = g & 16383, br = rem8 >> 4, c8 = (rem8 & 15) * 8, b = br >> 7, r = br & 127;
        store8_bf(F.out + O_KP + (size_t)which * 131072 + (size_t)br * 128 + c8, *(const v4u*)(ZA + ((size_t)b * SEQ + 1920 + r) * 768 + 512 + which * 128 + c8)); }
    for (int g0 = gt; g0 < 524288; g0 += 4 * GS) {
        f32x4 va[4], vb[4]; v4u vz[4]; float* dsts[4]; bool live[4], fromc[4];
#pragma unroll
        for (int it = 0; it < 4; ++it) { const int g = g0 + it * GS; live[it] = g < 524288;
            const int which = g >> 18, rem8 = g & 262143, br = rem8 >> 4, c8 = (rem8 & 15) * 8, b = br >> 7, r = br & 127;
            dsts[it] = F.out + O_KS + (size_t)which * 2097152 + (size_t)br * 128 + c8; fromc[it] = r < 120;
            if (live[it]) { if (fromc[it]) { const float* src = (which ? cache_v : cache_k) + ((size_t)b * 128 + r + 8) * 128 + c8; va[it] = *(const f32x4*)src; vb[it] = *(const f32x4*)(src + 4); }
                            else vz[it] = *(const v4u*)(ZA + ((size_t)MP + b * 8 + (r - 120)) * 768 + 512 + which * 128 + c8); } }
#pragma unroll
        for (int it = 0; it < 4; ++it) if (live[it]) { if (fromc[it]) { *(f32x4*)dsts[it] = va[it]; *(f32x4*)(dsts[it] + 4) = vb[it]; } else store8_bf(dsts[it], vz[it]); }
    }
    }
    if (PART == 1) {
    for (int g = gt; g < 4608; g += GS) { const int idx = g * 8, b = idx / 4608, j = (idx % 4608) / CONVD, c = idx % CONVD;
        store8_bf(F.out + O_CP + idx, *(const v4u*)(ZC + ((size_t)b * SEQ + 2045 + j) * CONVD + c)); }
    for (int g = gt; g < 73728; g += GS) { const int idx = g * 8, b = idx / 4608, j = (idx % 4608) / CONVD, c = idx % CONVD;
        store8_bf(F.out + O_CS + idx, *(const v4u*)(ZC + ((size_t)MP + b * 8 + 5 + j) * CONVD + c)); }
    }
}


struct Args { const float* in[25]; float* out; unsigned char* ws; };
typedef const __attribute__((address_space(4))) char* kaptr_t;
__device__ __forceinline__ const float* ldarg(int i) { kaptr_t ka = (kaptr_t)__builtin_amdgcn_kernarg_segment_ptr(); asm volatile("" : "+s"(ka)); return *(const float* const __attribute__((address_space(4)))*)(ka + 8 * i); }
#define ARG(i) ldarg(i)
__global__ void __launch_bounds__(NWAVES * 64, 2) mega_fwd(Args args) {
    extern __shared__ __attribute__((aligned(16))) unsigned char lds_raw[];
    Frame F;
    F.lds = (LAS unsigned char*)lds_raw;
    F.tid = threadIdx.x; F.lane = F.tid & 63; F.wave = __builtin_amdgcn_readfirstlane(F.tid >> 6);
    F.G = gridDim.x; { const int bx = blockIdx.x; F.vcu = (F.G % 8 == 0) ? (bx % 8) * (F.G / 8) + bx / 8 : bx; }
    F.out = (float*)ldarg(25); F.ws = (unsigned char*)ldarg(26);
    volatile LAS unsigned* MISC = (volatile LAS unsigned*)(F.lds + MISC_OFF);
    if (F.tid < 64) MISC[F.tid] = 0u;
    __syncthreads();
    XcdBarrier bar = xcd_barrier_post((unsigned*)(F.ws + WS_CTL) + CW_BAR, MISC + 8, F.tid == 0);
#define GRID_BAR() do { xcd_barrier(bar, F.tid == 0); int t_ = F.wave * 64 + hw_lane(); asm volatile("" : "+v"(t_)); F.tid = t_; F.lane = t_ & 63; } while (0)
    bf16* wb = (bf16*)(F.ws + WS_W); bf16* XN = (bf16*)(F.ws + WS_XN);
    bf16* ACT = (bf16*)(F.ws + WS_RA); bf16* ZA = (bf16*)(F.ws + WS_RA + RA_ZA); bf16* ZC = (bf16*)(F.ws + WS_RA + RA_ZC); bf16* ZZ = (bf16*)(F.ws + WS_RA + RA_ZZ);
    float* MB = (float*)(F.ws + WS_RB); bf16* SG = (bf16*)(F.ws + WS_RB);
    bf16* OA = (bf16*)(F.ws + WS_RC); bf16* OB = OA + (size_t)MROWS * 512;
    bf16* MB2v = (bf16*)(F.ws + WS_MB2) - (size_t)MP * DM;
    const int cu = (int)blockIdx.x;

    convert_ffn_weights(F, ARG(8), ARG(9), 0, 0, F.G == 256 ? 2816 : 4224, F.vcu, F.G);
    { const size_t gt = (size_t)F.vcu * 512 + F.tid; for (size_t i = gt; i < 8192; i += (size_t)F.G * 512) ((float*)(F.ws + WS_WAB))[i] = ARG(12)[(i >> 3) * INDIM + 2816 + (i & 7)]; }
    rowwise<0, 1>(F, nullptr, ARG(6), ARG(0), ARG(1), nullptr, nullptr);
    GRID_BAR();
    { pg8::Gemm g{XN, XN, wb + W_UP / 2, wb + W_UP / 2, DM, DM / 64}; pg8::StaticOrder S; S.init(MROWS, NUP, F.G, cu); pg8::EpiSwiglu E{ACT, FF};
      pg8::gemm_phase<pg8::EpiSwiglu, pg8::StaticOrder, true, true>(F.lds, g, S, E, F.wave); }
    if (F.G == 256 && cu >= 216) convert_ffn_weights(F, ARG(8), ARG(9), 0, 2816, 4224, cu - 216, 40);
    GRID_BAR();
    { pg8::Gemm g{ACT, ACT, wb + W_DOWN / 2, wb + W_DOWN / 2, FF, FF / 64}; pg8::SplitOrder S; S.so.init(MP, DM, F.G, cu); S.nsplit = 8; S.big_nt = 6; S.nbig = 6; S.small_nt = 4; pg8::EpiMB E{(bf16*)MB, DM, (float*)(F.ws + WS_RC)};
      pg8::gemm_phase<pg8::EpiMB, pg8::SplitOrder, true, true>(F.lds, g, S, E, F.wave); }
    static_assert(W_A + (size_t)DM * 512 * 2 <= W_DOWN, "early mixer weight copies stay below the FFN1 down weights");
    if (F.G == 256 && cu >= 128) convert_mix_weights(F, ARG(12), ARG(18), ARG(19), ARG(20), 0, 0, 2688, cu - 128, 128);
    GRID_BAR();
    { const float* wab = (const float*)(F.ws + WS_WAB); for (int i = F.tid; i < 8192; i += 512) { const int k = i >> 3, c = i & 7, jj = (k >> 9) * 2 + ((k & 7) >> 2); ((LAS float*)F.lds)[((((k & 3) * 4 + jj) * 64 + ((k & 511) >> 3)) * 8) + c] = wab[i]; } }
    if (F.G != 256) convert_mix_weights(F, ARG(12), ARG(18), ARG(19), ARG(20), 32768, 0, 3456, F.vcu, F.G);
    __syncthreads();
    rowwise<1, 8>(F, ARG(7), ARG(10), ARG(0), ARG(1), ARG(15), ARG(16));
    GRID_BAR();
    { pg8::Gemm g{XN, XN, wb + W_IN1 / 2, wb + W_IN1 / 2, DM, DM / 64}; pg8::StaticOrder S; S.init(MROWS, NZ1, F.G, cu); pg8::EpiBf16Z<0> E{ZA, ZC, ZZ, 768, 1536, 512, 3, 9};
      pg8::gemm_phase<pg8::EpiBf16Z<0>, pg8::StaticOrder, true, true>(F.lds, g, S, E, F.wave); }
    if (F.G == 256 && cu >= 236) convert_mix_weights(F, ARG(12), ARG(18), ARG(19), ARG(20), 0, 2688, 3456, cu - 236, 20);
    GRID_BAR();
    copy_outputs<1>(F, nullptr, nullptr, F.vcu, F.G);
    for (int u = F.vcu; u < 512; u += F.G) attn_unit<false>(F, nullptr, nullptr, ARG(13), u >> 6, (u >> 5) & 1, u & 31);
    for (int u = F.vcu; u < 256; u += F.G) attn_unit<true>(F, ARG(2), ARG(3), ARG(13), u >> 1, u & 1, 0);
    for (int u = F.vcu; u < 512; u += F.G) prep_pair(F, ARG(14), u);
    for (int u = F.vcu; u < 512; u += F.G) dn_sample_unit(F, ARG(4), ARG(5), ARG(14), ARG(17), u);
    GRID_BAR();
    for (int u = F.vcu; u < 256; u += F.G) scan_unit(F, u);
    GRID_BAR();
    { pg8::Gemm g{XN, XN, wb + W_G / 2, wb + W_G / 2, DM, DM / 64}; pg8::StaticOrder S; S.init(MROWS, NGATE, F.G, cu); pg8::EpiBf16Z<1> E{SG, SG, SG, 2048, 2048, 2048, 1000, 1000};
      pg8::gemm_phase<pg8::EpiBf16Z<1>, pg8::StaticOrder, true, true>(F.lds, g, S, E, F.wave); }
    gated_norm_prompt(F, ARG(17));
    { const int nbusy7 = (544 - 2 * F.G > 0 && 544 - 2 * F.G < F.G) ? 544 - 2 * F.G : 0;
      if ((int)blockIdx.x >= nbusy7) copy_outputs<0>(F, ARG(2), ARG(3), (int)blockIdx.x - nbusy7, F.G - nbusy7); }
    GRID_BAR();
    { pg8::Gemm g{OA, OB, wb + W_A / 2, wb + W_B / 2, 512, 8}; pg8::PairOrder2 S; S.so.init(MP, DM, F.G, cu); pg8::EpiMerge E{SG, XN, MB2v};
      pg8::gemm_phase<pg8::EpiMerge, pg8::PairOrder2, true, true>(F.lds, g, S, E, F.wave); }
    GRID_BAR();
    { pg8::Gemm g{XN, MB2v, wb + W_O / 2, wb + W_O / 2, DM, DM / 64}; pg8::SplitOrder2 S; S.so.init(MP, DM, F.G, cu); pg8::EpiMB E{(bf16*)MB, DM, (float*)(F.ws + WS_RC)};
      pg8::gemm_phase<pg8::EpiMB, pg8::SplitOrder2, true, true>(F.lds, g, S, E, F.wave); }
    static_assert(W_DOWN <= W_O, "up2 copy stays below W_O");
    if (F.G == 256 && cu >= 128) convert_ffn_weights(F, ARG(23), ARG(24), 0, 0, 2816, cu - 128, 128);
    GRID_BAR();
    if (F.G != 256) convert_ffn_weights(F, ARG(23), ARG(24), 0, 0, 4224, F.vcu, F.G);
    rowwise<2, 8>(F, ARG(11), ARG(21), nullptr, nullptr, nullptr, nullptr);
    GRID_BAR();
    { pg8::Gemm g{XN, XN, wb + W_UP / 2, wb + W_UP / 2, DM, DM / 64}; pg8::StaticOrder S; S.init(MROWS, NUP, F.G, cu); pg8::EpiSwiglu E{ACT, FF};
      pg8::gemm_phase<pg8::EpiSwiglu, pg8::StaticOrder, true, true>(F.lds, g, S, E, F.wave); }
    if (F.G == 256 && cu >= 216) convert_ffn_weights(F, ARG(23), ARG(24), 0, 2816, 4224, cu - 216, 40);
    GRID_BAR();
    { pg8::Gemm g{ACT, ACT, wb + W_DOWN / 2, wb + W_DOWN / 2, FF, FF / 64}; pg8::SplitOrder S; S.so.init(MP, DM, F.G, cu); S.nsplit = 8; S.big_nt = 6; S.nbig = 6; S.small_nt = 4; pg8::EpiMB E{(bf16*)MB, DM, (float*)(F.ws + WS_RC)};
      pg8::gemm_phase<pg8::EpiMB, pg8::SplitOrder, true, true>(F.lds, g, S, E, F.wave); }
    GRID_BAR();
    rowwise<3, 8>(F, ARG(22), nullptr, nullptr, nullptr, nullptr, nullptr);
}

extern "C" void kernel_launch(void* const* d_in, const int* in_sizes, int n_in, void* d_out, int out_size, void* d_ws, size_t ws_size, hipStream_t stream) {
    static int grid = 0;
    if (grid == 0) {
        if (n_in != 25 || out_size != (int)O_END || ws_size < WS_END) { fprintf(stderr, "kernel_launch: unexpected problem shape (n_in %d out %d ws %zu)\n", n_in, out_size, ws_size); grid = -1; return; }
        int dev = 0, cus = 0, per_cu = 0;
        if (hipGetDevice(&dev) != hipSuccess || hipDeviceGetAttribute(&cus, hipDeviceAttributeMultiprocessorCount, dev) != hipSuccess) { grid = -1; return; }
        if (hipFuncSetAttribute((const void*)mega_fwd, hipFuncAttributeMaxDynamicSharedMemorySize, LDS_BYTES) != hipSuccess) { fprintf(stderr, "kernel_launch: hipFuncSetAttribute failed\n"); grid = -1; return; }
        if (hipOccupancyMaxActiveBlocksPerMultiprocessor(&per_cu, (const void*)mega_fwd, NWAVES * 64, LDS_BYTES) != hipSuccess || per_cu < 1) { fprintf(stderr, "kernel_launch: occupancy query reports %d\n", per_cu); }
        (void)hipGetLastError();
        grid = cus;
    }
    if (grid < 0) return;
    (void)hipMemsetAsync((char*)d_ws + WS_CTL, 0, CTL_ZERO_BYTES, stream);
    Args a{};
    for (int i = 0; i < 25; ++i) a.in[i] = (const float*)d_in[i];
    a.out = (float*)d_out; a.ws = (unsigned char*)d_ws;
    hipLaunchKernelGGL(mega_fwd, dim3(grid), dim3(NWAVES * 64), LDS_BYTES, stream, a);
}
```

```cpp
#include <hip/hip_runtime.h>
#include <cstdio>
#include <cstdint>

constexpr int DM = 1024, NBATCH = 8, SEQ = 2048, DBATCH = 128, DSEQ = 8;
constexpr int MP = NBATCH * SEQ, MS = DBATCH * DSEQ, MROWS = MP + MS;
constexpr int FF = 2816, NUP = 2 * FF, CONVD = 1536, INDIM = 4872;
constexpr int NZ1 = 2816, NGATE = 2048;
constexpr float EPS = 1e-6f;
constexpr size_t O_Y = 0, O_KP = 17825792, O_VP = O_KP + 131072, O_CP = O_VP + 131072, O_DP = O_CP + 36864, O_KS = O_DP + 524288, O_VS = O_KS + 2097152,
                 O_CS = O_VS + 2097152, O_DS = O_CS + 589824, O_END = O_DS + 8388608;
static_assert(O_END == 31821824, "output size");

__device__ __forceinline__ int hw_lane() { int l; asm volatile("v_mbcnt_lo_u32_b32 %0, -1, 0\n\tv_mbcnt_hi_u32_b32 %0, -1, %0" : "=v"(l)); return l; }
namespace pg8 {
#define PG8_LAS __attribute__((address_space(3)))
typedef unsigned short bf16_t;
typedef short bf16x8 __attribute__((ext_vector_type(8)));
typedef float f32x4 __attribute__((ext_vector_type(4)));
typedef unsigned u32x4 __attribute__((ext_vector_type(4)));
constexpr int BM = 256, BK = 64, HALF = 128, HTB = HALF * BK * 2  , STAGE_BYTES = 8 * HTB, NXCD = 8, WGM = 8;

__host__ __device__ __forceinline__ int lds_byte(int r, int c) { const int st = (r >> 4) * 2 + (c >> 5), rr = r & 15, cc = c & 31, ob = rr * 64 + cc * 2; return st * 1024 + (ob ^ (((ob >> 9) & 1) << 5)); }
__host__ __device__ __forceinline__ void stage_rc(int b, int& R, int& C) { const int st = b / 1024, sb = b % 1024, swz = sb ^ (((sb >> 9) & 1) << 5); R = (st >> 1) * 16 + swz / 64; C = (st & 1) * 32 + (swz % 64) / 2; }
__host__ __device__ __forceinline__ int perm32(int rho) { const int n = rho >> 4, i = rho & 15; return 8 * (i >> 2) + 4 * n + (i & 3); }

struct Unit { int pm, pn, br, kt0, nt, split; };
struct Gemm { const bf16_t* A0; const bf16_t* A1; const bf16_t* B0; const bf16_t* B1; int K; int nt; };

struct StaticOrder {
    int nM, nN, nwg, G, c;
    __device__ void init(int M, int N, int G_, int c_) { nM = M / BM; nN = N / BM; nwg = nM * nN; G = G_; c = c_; }
    __device__ void map(int L, Unit& u) const {
        int wgid = L; { const int q = nwg / NXCD, r = nwg % NXCD, xcd = wgid % NXCD, off = wgid / NXCD; wgid = (xcd < r ? xcd * (q + 1) : r * (q + 1) + (xcd - r) * q) + off; }
        const int nig = WGM * nN, gid = wgid / nig, fm = gid * WGM, gsz = (nM - fm) < WGM ? (nM - fm) : WGM;
        u.pm = fm + ((wgid % nig) % gsz); u.pn = (wgid % nig) / gsz; u.br = 0; u.kt0 = 0; u.nt = 0; u.split = -1;
    }
    __device__ bool next(int i, Unit& u) const { const long L = (long)i * G + c; if (L >= nwg) return false; map((int)L, u); return true; }
};
struct PairOrder {
    StaticOrder so;
    __device__ bool next(int i, Unit& u) const { const long L = (long)(i >> 1) * so.G + so.c; if (L >= so.nwg) return false; so.map((int)L, u); u.br = i & 1; return true; }
};

struct PairOrder2 {
    StaticOrder so;
    __device__ bool next(int i, Unit& u) const {
        if (i < 2) { if (so.c >= so.nwg) return false; so.map(so.c, u); u.br = i; return true; }
        if (i == 2) { const int j = so.c; if (j >= 32) return false; const int tile = j >> 1; u.pm = 64 + (tile >> 2); u.pn = tile & 3; u.br = j & 1; u.kt0 = 0; u.nt = 0; u.split = 0; return true; }
        return false;
    }
};
struct SplitOrder2 {
    StaticOrder so;
    __device__ bool next(int i, Unit& u) const {
        if (i == 0) { if (so.c >= so.nwg) return false; so.map(so.c, u); return true; }
        if (i == 1) { const int j = so.c; if (j >= 128) return false; const int tile = j >> 3, sp = j & 7; u.pm = 64 + (tile >> 2); u.pn = tile & 3; u.br = sp >> 2; u.nt = 4; u.kt0 = 4 * (sp & 3); u.split = sp; return true; }
        return false;
    }
};
struct SplitOrder {
    StaticOrder so; int nsplit, big_nt, nbig, small_nt;
    __device__ bool next(int i, Unit& u) const {
        if (i == 0) { if (so.c >= so.nwg) return false; so.map(so.c, u); return true; }
        if (i == 1) { const int j = so.c; if (j >= 16 * nsplit) return false; const int tile = j / nsplit, sp = j % nsplit;
            u.pm = 64 + (tile >> 2); u.pn = tile & 3; u.br = 0; u.split = sp;
            if (sp < nbig) { u.nt = big_nt; u.kt0 = sp * big_nt; } else { u.nt = small_nt; u.kt0 = nbig * big_nt + (sp - nbig) * small_nt; }
            return true; }
        return false;
    }
};
typedef float f32x2_cv __attribute__((ext_vector_type(2))); typedef __bf16 bf16x2_cv __attribute__((ext_vector_type(2)));
__device__ __forceinline__ unsigned cvt_pk_bf16(float lo, float hi) { f32x2_cv v = {lo, hi}; bf16x2_cv b = __builtin_convertvector(v, bf16x2_cv); return __builtin_bit_cast(unsigned, b); }
__device__ __forceinline__ float bflo(unsigned w) { return __builtin_bit_cast(float, w << 16); }
__device__ __forceinline__ float bfhi(unsigned w) { return __builtin_bit_cast(float, w & 0xffff0000u); }
__device__ __forceinline__ float sigm(float x) { return __builtin_amdgcn_rcpf(1.0f + __expf(-x)); }

typedef f32x4 Acc[2][2][4][2];

struct EpiSwiglu {
    static constexpr bool PERM = true;
    bf16_t* O; int ldc;
    __device__ __forceinline__ bool keep(const Unit&) const { return false; }
    __device__ __forceinline__ void operator()(Acc& acc, const Unit& u, int wr, int wc, int fr, int fq) const {
        const int row0 = u.pm * BM + wr * 64 + fr, col0 = u.pn * HALF + wc * 32 + 8 * fq;
#pragma unroll
        for (int ai = 0; ai < 2; ++ai)
#pragma unroll
            for (int m = 0; m < 4; ++m) {
                float o[8];
#pragma unroll
                for (int n = 0; n < 2; ++n)
#pragma unroll
                    for (int j = 0; j < 4; ++j) { const float g = acc[ai][0][m][n][j], up = acc[ai][1][m][n][j]; o[4 * n + j] = g * sigm(g) * up; }
                u32x4 w; w.x = cvt_pk_bf16(o[0], o[1]); w.y = cvt_pk_bf16(o[2], o[3]); w.z = cvt_pk_bf16(o[4], o[5]); w.w = cvt_pk_bf16(o[6], o[7]);
                *(u32x4*)(O + (size_t)(row0 + ai * HALF + m * 16) * ldc + col0) = w;
            }
    }
};
struct EpiF32 {
    static constexpr bool PERM = false;
    float* O; int ldc; float* P;
    __device__ __forceinline__ bool keep(const Unit&) const { return false; }
    __device__ __forceinline__ void operator()(Acc& acc, const Unit& u, int wr, int wc, int fr, int fq) const {
        const int row0 = u.pm * BM + wr * 64 + fr, col0 = u.pn * BM + wc * 32 + 4 * fq;
        float* base = u.split < 0 ? O : P + ((size_t)u.split * MS - MP) * ldc;
#pragma unroll
        for (int ai = 0; ai < 2; ++ai)
#pragma unroll
            for (int m = 0; m < 4; ++m) { float* rowp = base + (size_t)(row0 + ai * HALF + m * 16) * ldc + col0;
#pragma unroll
                for (int bj = 0; bj < 2; ++bj)
#pragma unroll
                    for (int n = 0; n < 2; ++n) *(f32x4*)(rowp + bj * HALF + n * 16) = acc[ai][bj][m][n]; }
    }
};
struct EpiMB {
    static constexpr bool PERM = true;
    bf16_t* O; int ldc; float* P;
    __device__ __forceinline__ bool keep(const Unit&) const { return false; }
    __device__ __forceinline__ void operator()(Acc& acc, const Unit& u, int wr, int wc, int fr, int fq) const {
        const int row0 = u.pm * BM + wr * 64 + fr, col0 = u.pn * BM + wc * 32 + 8 * fq;
        if (u.split < 0) {
#pragma unroll
            for (int ai = 0; ai < 2; ++ai)
#pragma unroll
                for (int m = 0; m < 4; ++m) { bf16_t* rowp = O + (size_t)(row0 + ai * HALF + m * 16) * ldc + col0;
#pragma unroll
                    for (int bj = 0; bj < 2; ++bj) { const f32x4 v0 = acc[ai][bj][m][0], v1 = acc[ai][bj][m][1];
                        u32x4 w; w.x = cvt_pk_bf16(v0[0], v0[1]); w.y = cvt_pk_bf16(v0[2], v0[3]); w.z = cvt_pk_bf16(v1[0], v1[1]); w.w = cvt_pk_bf16(v1[2], v1[3]);
                        *(u32x4*)(rowp + bj * HALF) = w; } }
        } else {
            float* base = P + ((size_t)u.split * MS - MP) * ldc;
#pragma unroll
            for (int ai = 0; ai < 2; ++ai)
#pragma unroll
                for (int m = 0; m < 4; ++m) { float* rowp = base + (size_t)(row0 + ai * HALF + m * 16) * ldc + col0;
#pragma unroll
                    for (int bj = 0; bj < 2; ++bj) { *(f32x4*)(rowp + bj * HALF) = acc[ai][bj][m][0]; *(f32x4*)(rowp + bj * HALF + 4) = acc[ai][bj][m][1]; } }
        }
    }
};
template <int ACT  > struct EpiBf16Z {
    static constexpr bool PERM = true;
    bf16_t* O0; bf16_t* O1; bf16_t* O2; int ld0, ld1, ld2, t1, t2;
    __device__ __forceinline__ bool keep(const Unit&) const { return false; }
    __device__ __forceinline__ void operator()(Acc& acc, const Unit& u, int wr, int wc, int fr, int fq) const {
        bf16_t* base; int ld, pn = u.pn;
        if (pn < t1) { base = O0; ld = ld0; } else if (pn < t2) { base = O1; ld = ld1; pn -= t1; } else { base = O2; ld = ld2; pn -= t2; }
        const int row0 = u.pm * BM + wr * 64 + fr, col0 = pn * BM + wc * 32 + 8 * fq;
#pragma unroll
        for (int ai = 0; ai < 2; ++ai)
#pragma unroll
            for (int m = 0; m < 4; ++m) { bf16_t* rowp = base + (size_t)(row0 + ai * HALF + m * 16) * ld + col0;
#pragma unroll
                for (int bj = 0; bj < 2; ++bj) { f32x4 v0 = acc[ai][bj][m][0], v1 = acc[ai][bj][m][1];
                    if (ACT == 1) {
#pragma unroll
                        for (int j = 0; j < 4; ++j) { v0[j] = sigm(v0[j]); v1[j] = sigm(v1[j]); } }
                    u32x4 w; w.x = cvt_pk_bf16(v0[0], v0[1]); w.y = cvt_pk_bf16(v0[2], v0[3]); w.z = cvt_pk_bf16(v1[0], v1[1]); w.w = cvt_pk_bf16(v1[2], v1[3]);
                    *(u32x4*)(rowp + bj * HALF) = w; } }
    }
};
struct EpiMerge {
    static constexpr bool PERM = true;
    const bf16_t* SG; bf16_t* O; bf16_t* O2;
    __device__ __forceinline__ bool keep(const Unit& u) const { return u.split < 0 && u.br == 0; }
    __device__ __forceinline__ void operator()(Acc& acc, const Unit& u, int wr, int wc, int fr, int fq) const {
        const int row0 = u.pm * BM + wr * 64 + fr, col0 = u.pn * BM + wc * 32 + 8 * fq;
#pragma unroll
        for (int ai = 0; ai < 2; ++ai)
#pragma unroll
            for (int m = 0; m < 4; ++m) { const size_t row = (size_t)(row0 + ai * HALF + m * 16);
#pragma unroll
                for (int bj = 0; bj < 2; ++bj) {
                    if (u.split >= 0) {
                        const u32x4 sg = *(const u32x4*)(SG + row * 2048 + (u.br ? 1024 : 0) + col0 + bj * HALF);
                        const float gg[8] = {bflo(sg.x), bfhi(sg.x), bflo(sg.y), bfhi(sg.y), bflo(sg.z), bfhi(sg.z), bflo(sg.w), bfhi(sg.w)};
                        float o[8];
#pragma unroll
                        for (int n = 0; n < 2; ++n)
#pragma unroll
                            for (int j = 0; j < 4; ++j) o[4 * n + j] = acc[ai][bj][m][n][j] * gg[4 * n + j];
                        u32x4 w; w.x = cvt_pk_bf16(o[0], o[1]); w.y = cvt_pk_bf16(o[2], o[3]); w.z = cvt_pk_bf16(o[4], o[5]); w.w = cvt_pk_bf16(o[6], o[7]);
                        *(u32x4*)((u.br ? O2 : O) + row * 1024 + col0 + bj * HALF) = w;
                        continue;
                    }
                    const u32x4 sb = *(const u32x4*)(SG + row * 2048 + 1024 + col0 + bj * HALF);
                    float b[8] = {bflo(sb.x), bfhi(sb.x), bflo(sb.y), bfhi(sb.y), bflo(sb.z), bfhi(sb.z), bflo(sb.w), bfhi(sb.w)};
                    if (u.br == 0) {
                        const u32x4 sa = *(const u32x4*)(SG + row * 2048 + col0 + bj * HALF);
                        float a[8] = {bflo(sa.x), bfhi(sa.x), bflo(sa.y), bfhi(sa.y), bflo(sa.z), bfhi(sa.z), bflo(sa.w), bfhi(sa.w)};
#pragma unroll
                        for (int n = 0; n < 2; ++n)
#pragma unroll
                            for (int j = 0; j < 4; ++j) acc[ai][bj][m][n][j] *= a[4 * n + j] * __builtin_amdgcn_rcpf(b[4 * n + j]);
                    } else {
                        float o[8];
#pragma unroll
                        for (int n = 0; n < 2; ++n)
#pragma unroll
                            for (int j = 0; j < 4; ++j) o[4 * n + j] = acc[ai][bj][m][n][j] * b[4 * n + j];
                        u32x4 w; w.x = cvt_pk_bf16(o[0], o[1]); w.y = cvt_pk_bf16(o[2], o[3]); w.z = cvt_pk_bf16(o[4], o[5]); w.w = cvt_pk_bf16(o[6], o[7]);
                        *(u32x4*)(O + row * 1024 + col0 + bj * HALF) = w;
                    }
                } }
    }
};

template <class Epi, class Sched, bool ALIGN_EPI = false, bool SP2 = false>
__device__ __forceinline__ void gemm_phase(PG8_LAS unsigned char* lds, const Gemm g, const Sched& S, const Epi& E, int wave_id) {
    int tid_ = wave_id * 64 + hw_lane(); asm volatile("" : "+v"(tid_));
    const int tid = tid_, wid = __builtin_amdgcn_readfirstlane(tid >> 6), lane = tid & 63, wr = wid >> 2, wc = wid & 3, fr = lane & 15, fq = lane >> 4;
    const int K = g.K, nt = g.nt;
    unsigned voffA[2], voffB[2];
#pragma unroll
    for (int i = 0; i < 2; ++i) { int R, C; stage_rc(tid * 16 + i * 8192, R, C); const int Rb = Epi::PERM ? ((R & ~31) + perm32(R & 31)) : R;
        voffA[i] = (unsigned)(R * K + C) * 2u; voffB[i] = (unsigned)(Rb * K + C) * 2u; }
    const size_t kstep = (size_t)(BK * 2);
    const size_t hstep = (size_t)HALF * K * 2;
    const size_t tstep = 2 * hstep;
    const unsigned ldsw = (unsigned)wid * 1024u;
    const int aoff = lds_byte(wr * 64 + fr, fq * 8), boff = lds_byte(wc * 32 + fr, fq * 8);
#define PG8_SA(b, h) (((b) * 2 + (h)) * HTB)
#define PG8_SB(b, h) ((4 + (b) * 2 + (h)) * HTB)
#define PG8_STAGE(bufoff, gbase, voff) do { _Pragma("unroll") for (int _i = 0; _i < 2; ++_i) \
        __builtin_amdgcn_global_load_lds((const unsigned*)((const char*)(gbase) + (voff)[_i]), (PG8_LAS unsigned*)(lds + (bufoff) + ldsw + _i * 8192), 16, 0, 0); } while (0)
#define PG8_LDA(dst, b, h) do { _Pragma("unroll") for (int m = 0; m < 4; ++m) _Pragma("unroll") for (int k = 0; k < 2; ++k) dst[m][k] = *(const PG8_LAS bf16x8*)(lds + PG8_SA(b, h) + aoff + m * 2048 + k * 1024); } while (0)
#define PG8_LDB(dst, b, h) do { _Pragma("unroll") for (int n = 0; n < 2; ++n) _Pragma("unroll") for (int k = 0; k < 2; ++k) dst[n][k] = *(const PG8_LAS bf16x8*)(lds + PG8_SB(b, h) + boff + n * 2048 + k * 1024); } while (0)
#define PG8_MMA(ai, bj, At, Bt) do { __builtin_amdgcn_s_setprio(1); _Pragma("unroll") for (int m = 0; m < 4; ++m) _Pragma("unroll") for (int n = 0; n < 2; ++n) _Pragma("unroll") for (int k = 0; k < 2; ++k) \
        acc[ai][bj][m][n] = __builtin_amdgcn_mfma_f32_16x16x32_bf16(Bt[n][k], At[m][k], acc[ai][bj][m][n], 0, 0, 0); __builtin_amdgcn_s_setprio(0); } while (0)
#define PG8_WAIT_V(n) asm volatile("s_waitcnt vmcnt(" #n ")" ::: "memory")
#define PG8_WAIT_L(n) asm volatile("s_waitcnt lgkmcnt(" #n ")" ::: "memory")
#define PG8_BAR __builtin_amdgcn_s_barrier()
#define PG8_SCHED __builtin_amdgcn_sched_barrier(0)
    Unit cur, nxt; int ui = 0;
    if (!S.next(0, cur)) return;
    f32x4 acc[2][2][4][2];
#pragma unroll
    for (int a = 0; a < 2; ++a)
#pragma unroll
        for (int b = 0; b < 2; ++b)
#pragma unroll
            for (int m = 0; m < 4; ++m)
#pragma unroll
                for (int n = 0; n < 2; ++n) acc[a][b][m][n] = (f32x4){0.f, 0.f, 0.f, 0.f};
    bf16x8 At[4][2], B0[2][2], B1[2][2];
    const char* cA = (const char*)(cur.br ? g.A1 : g.A0) + (size_t)cur.pm * tstep + (size_t)cur.kt0 * kstep; const char* cB = (const char*)(cur.br ? g.B1 : g.B0) + (size_t)cur.pn * tstep + (size_t)cur.kt0 * kstep;
    int cnt = cur.nt ? cur.nt : nt;
    if constexpr (SP2) {
        PG8_STAGE(PG8_SB(0, 0), cB, voffB); PG8_STAGE(PG8_SB(0, 1), cB + hstep, voffB); PG8_STAGE(PG8_SA(0, 0), cA, voffA); PG8_STAGE(PG8_SA(0, 1), cA + hstep, voffA);
        if (wr == 1) PG8_BAR;
        PG8_WAIT_V(2); PG8_BAR;
        PG8_STAGE(PG8_SB(1, 0), cB + kstep, voffB); PG8_STAGE(PG8_SA(1, 0), cA + kstep, voffA); PG8_STAGE(PG8_SB(1, 1), cB + hstep + kstep, voffB);
        PG8_WAIT_V(6); PG8_BAR;
    } else {
        PG8_STAGE(PG8_SB(0, 0), cB, voffB); PG8_STAGE(PG8_SA(0, 0), cA, voffA); PG8_STAGE(PG8_SB(0, 1), cB + hstep, voffB); PG8_STAGE(PG8_SA(0, 1), cA + hstep, voffA);
        if (wr == 1) PG8_BAR;
        PG8_WAIT_V(4); PG8_BAR;
        PG8_STAGE(PG8_SB(1, 0), cB + kstep, voffB); PG8_STAGE(PG8_SA(1, 0), cA + kstep, voffA); PG8_STAGE(PG8_SB(1, 1), cB + hstep + kstep, voffB);
        PG8_WAIT_V(6); PG8_BAR;
    }
    for (;;) {
        const bool has_next = S.next(ui + 1, nxt);
        const char* nA = has_next ? (const char*)(nxt.br ? g.A1 : g.A0) + (size_t)nxt.pm * tstep + (size_t)nxt.kt0 * kstep : cA; const char* nB = has_next ? (const char*)(nxt.br ? g.B1 : g.B0) + (size_t)nxt.pn * tstep + (size_t)nxt.kt0 * kstep : cB;
        for (int t = 0; t < cnt; t += 2) {
            const bool last = (t == cnt - 2);
            const char* a1 = cA + (size_t)(t + 1) * kstep;
            const char* a2 = last ? nA : cA + (size_t)(t + 2) * kstep; const char* b2 = last ? nB : cB + (size_t)(t + 2) * kstep;
            const char* a3 = a2 + kstep; const char* b3 = b2 + kstep;
            if constexpr (SP2) {
            PG8_LDB(B0, 0, 0); PG8_LDB(B1, 0, 1); PG8_SCHED; PG8_LDA(At, 0, 0); PG8_STAGE(PG8_SA(1, 1), a1 + hstep, voffA);
            PG8_WAIT_V(8); PG8_WAIT_L(0); PG8_BAR; PG8_MMA(0, 0, At, B0); PG8_MMA(0, 1, At, B1); PG8_BAR; PG8_SCHED;
            PG8_LDA(At, 0, 1); PG8_STAGE(PG8_SB(0, 0), b2, voffB); PG8_STAGE(PG8_SB(0, 1), b2 + hstep, voffB); PG8_STAGE(PG8_SA(0, 0), a2, voffA);
            PG8_WAIT_V(8); PG8_WAIT_L(0); PG8_BAR; PG8_MMA(1, 0, At, B0); PG8_MMA(1, 1, At, B1); PG8_BAR; PG8_SCHED;
            PG8_LDB(B0, 1, 0); PG8_LDB(B1, 1, 1); PG8_SCHED; PG8_LDA(At, 1, 0); PG8_STAGE(PG8_SA(0, 1), a2 + hstep, voffA);
            PG8_WAIT_V(8); PG8_WAIT_L(0); PG8_BAR; PG8_MMA(0, 0, At, B0); PG8_MMA(0, 1, At, B1); PG8_BAR; PG8_SCHED;
            PG8_LDA(At, 1, 1); PG8_STAGE(PG8_SB(1, 0), b3, voffB); PG8_STAGE(PG8_SB(1, 1), b3 + hstep, voffB); PG8_STAGE(PG8_SA(1, 0), a3, voffA);
            PG8_WAIT_V(8); PG8_WAIT_L(0); PG8_BAR; PG8_MMA(1, 0, At, B0); PG8_MMA(1, 1, At, B1); PG8_BAR; PG8_SCHED;
            } else {
            PG8_LDB(B0, 0, 0); PG8_SCHED; PG8_LDA(At, 0, 0); PG8_STAGE(PG8_SA(1, 1), a1 + hstep, voffA);
            PG8_WAIT_L(8); PG8_BAR; PG8_WAIT_L(0); PG8_MMA(0, 0, At, B0); PG8_BAR; PG8_SCHED;
            PG8_LDB(B1, 0, 1); PG8_STAGE(PG8_SB(0, 0), b2, voffB);
            PG8_BAR; PG8_WAIT_L(0); PG8_MMA(0, 1, At, B1); PG8_BAR;
            PG8_LDA(At, 0, 1); PG8_STAGE(PG8_SA(0, 0), a2, voffA);
            PG8_BAR; PG8_WAIT_L(0); PG8_MMA(1, 0, At, B0); PG8_BAR; PG8_SCHED;
            PG8_STAGE(PG8_SB(0, 1), b2 + hstep, voffB);
            PG8_WAIT_V(6); PG8_BAR; PG8_MMA(1, 1, At, B1); PG8_BAR;
            PG8_LDB(B0, 1, 0); PG8_SCHED; PG8_LDA(At, 1, 0); PG8_STAGE(PG8_SA(0, 1), a2 + hstep, voffA);
            PG8_WAIT_L(8); PG8_BAR; PG8_WAIT_L(0); PG8_MMA(0, 0, At, B0); PG8_BAR; PG8_SCHED;
            PG8_LDB(B1, 1, 1); PG8_STAGE(PG8_SB(1, 0), b3, voffB);
            PG8_BAR; PG8_WAIT_L(0); PG8_MMA(0, 1, At, B1); PG8_BAR;
            PG8_LDA(At, 1, 1); PG8_STAGE(PG8_SA(1, 0), a3, voffA);
            PG8_BAR; PG8_WAIT_L(0); PG8_MMA(1, 0, At, B0); PG8_BAR; PG8_SCHED;
            PG8_STAGE(PG8_SB(1, 1), b3 + hstep, voffB);
            PG8_WAIT_V(6); PG8_BAR; PG8_MMA(1, 1, At, B1); PG8_BAR;
            }
        }
        if constexpr (ALIGN_EPI) { if (wr == 0) PG8_BAR; }
        E(acc, cur, wr, wc, fr, fq);
        if (!has_next) break;
        if (!E.keep(cur)) {
#pragma unroll
        for (int a = 0; a < 2; ++a)
#pragma unroll
            for (int b = 0; b < 2; ++b)
#pragma unroll
                for (int m = 0; m < 4; ++m)
#pragma unroll
                    for (int n = 0; n < 2; ++n) acc[a][b][m][n] = (f32x4){0.f, 0.f, 0.f, 0.f};
        }
        cur = nxt; cA = nA; cB = nB; ++ui; cnt = cur.nt ? cur.nt : nt;
        if constexpr (ALIGN_EPI) { if (wr == 1) PG8_BAR; }
    }
    PG8_WAIT_V(0);
    if constexpr (!ALIGN_EPI) { if (wr == 0) PG8_BAR; }
    PG8_BAR;
#undef PG8_SA
#undef PG8_SB
#undef PG8_STAGE
#undef PG8_LDA
#undef PG8_LDB
#undef PG8_MMA
#undef PG8_WAIT_V
#undef PG8_WAIT_L
#undef PG8_BAR
#undef PG8_SCHED
}
}
#define GAS __attribute__((address_space(1)))
#define LAS __attribute__((address_space(3)))
typedef unsigned short bf16;
typedef unsigned v4u __attribute__((ext_vector_type(4)));
typedef float f32x4 __attribute__((ext_vector_type(4)));
typedef short bf16x8 __attribute__((ext_vector_type(8)));
typedef GAS unsigned gu32;
typedef GAS unsigned long long gu64;
#define RLX_AGENT __ATOMIC_RELAXED, __HIP_MEMORY_SCOPE_AGENT
#define LDS_WAIT() asm volatile("s_waitcnt lgkmcnt(0)" ::: "memory")
#define VM_WAIT() asm volatile("s_waitcnt vmcnt(0)" ::: "memory")
__device__ __forceinline__ unsigned long long rt() { return __builtin_amdgcn_s_memrealtime(); }
__device__ __forceinline__ unsigned f2bf(float f) { unsigned u = __builtin_bit_cast(unsigned, f); return (u + 0x7fffu + ((u >> 16) & 1u)) >> 16; }
__device__ __forceinline__ unsigned pk2(float lo, float hi) { return f2bf(lo) | (f2bf(hi) << 16); }

#define XB_TMO      128
#define XB_XCNT(j)  (256  + 64 * (j))
#define XB_XSUB(j)  (1280 + 64 * (j))
#define XB_XGEN(j)  (2304 + 64 * (j))
#define XB_TOP      3328
#define XB_TOPGEN   3392
#define XCD_BAR_WORDS 3456
#define XB_SPIN_CAP (1u << 18)

__device__ __forceinline__ unsigned xb_ld(unsigned* p)              { return __hip_atomic_load(p, __ATOMIC_RELAXED, __HIP_MEMORY_SCOPE_AGENT); }
__device__ __forceinline__ unsigned xb_add(unsigned* p, unsigned v) { return __hip_atomic_fetch_add(p, v, __ATOMIC_RELAXED, __HIP_MEMORY_SCOPE_AGENT); }
__device__ __forceinline__ unsigned xb_xcc_id() { return (unsigned)__builtin_amdgcn_s_getreg((3 << 11) | 20) & 0xFu; }
#define XB_SPIN(cond, bar) do { unsigned _sp = 0; while (cond) { __builtin_amdgcn_s_sleep(1); \
    if ((++_sp & 255u) == 0u) { if (xb_ld(&(bar)[XB_TMO])) break; if (_sp > XB_SPIN_CAP) { atomicAdd(&(bar)[XB_TMO], 1u); break; } } } } while (0)

struct XcdBarrier {
    unsigned* bar; unsigned x;
    volatile LAS unsigned* st;
};

__device__ __forceinline__ XcdBarrier xcd_barrier_post(unsigned* bar, volatile LAS unsigned* st, bool tid0) {
    XcdBarrier b; b.bar = bar; b.x = xb_xcc_id(); b.st = st;
    if (tid0) (void)xb_add(&bar[XB_XCNT(b.x)], 1u);
    return b;
}
__device__ __forceinline__ void xcd_barrier_complete(unsigned* bar, unsigned x, unsigned& nloc, unsigned& nx) {
    const unsigned G = gridDim.x * gridDim.y * gridDim.z;
    unsigned sum, cnt, mine, sp = 0u;
    for (;;) {
        sum = 0u; cnt = 0u; mine = 0u;
#pragma unroll
        for (unsigned j = 0; j < 16; ++j) { const unsigned c = xb_ld(&bar[XB_XCNT(j)]); sum += c; cnt += (c > 0u) ? 1u : 0u; mine = (j == x) ? c : mine; }
        if (sum == G) break;
        __builtin_amdgcn_s_sleep(1);
        if ((++sp & 255u) == 0u) { if (xb_ld(&bar[XB_TMO])) break; if (sp > XB_SPIN_CAP) { atomicAdd(&bar[XB_TMO], 1u); break; } }
    }
    nloc = mine > 0u ? mine : 1u; nx = cnt > 0u ? cnt : 1u;
}

__device__ __forceinline__ void xcd_barrier(const XcdBarrier& b, bool tid0) {
    asm volatile("s_waitcnt vmcnt(0)" ::: "memory");
    __syncthreads();
    if (tid0) {
        unsigned* bar = b.bar;
        __builtin_amdgcn_s_waitcnt(0);
        unsigned nloc = b.st[0], nx = b.st[1];
        if (nloc == 0u) { xcd_barrier_complete(bar, b.x, nloc, nx); b.st[0] = nloc; b.st[1] = nx; }
        const unsigned old = xb_add(&bar[XB_XSUB(b.x)], 1u);
        const unsigned gen = old / nloc;
        if (old + 1u == (gen + 1u) * nloc) {
            __builtin_amdgcn_fence(__ATOMIC_RELEASE, "agent");
            asm volatile("s_waitcnt vmcnt(0)" ::: "memory");
            const unsigned og = xb_add(&bar[XB_TOP], 1u);
            const unsigned tg = og / nx;
            if (og + 1u == (tg + 1u) * nx) xb_add(&bar[XB_TOPGEN], 1u);
            else XB_SPIN(xb_ld(&bar[XB_TOPGEN]) == tg, bar);
            __builtin_amdgcn_fence(__ATOMIC_ACQUIRE, "agent");
            xb_add(&bar[XB_XGEN(b.x)], 1u);
            asm volatile("s_waitcnt vmcnt(0)" ::: "memory");
        } else {
            XB_SPIN(xb_ld(&bar[XB_XGEN(b.x)]) == gen, bar);
            __builtin_amdgcn_fence(__ATOMIC_ACQUIRE, "agent");
            asm volatile("s_waitcnt vmcnt(0)" ::: "memory");
        }
    }
    __syncthreads();
}
typedef unsigned v2u __attribute__((ext_vector_type(2)));

constexpr size_t MiB = 1u << 20;
constexpr size_t WS_CTL = 0, CTL_ZERO_BYTES = 64 * 1024;
constexpr size_t WS_W = 1 * MiB;
constexpr size_t W_UP = 0, W_DOWN = (size_t)NUP * DM * 2;
constexpr size_t W_IN1 = 0, W_G = (size_t)NZ1 * DM * 2, W_A = W_G + (size_t)NGATE * DM * 2, W_B = W_A + (size_t)DM * 512 * 2, W_O = W_B + (size_t)DM * 512 * 2;
static_assert(W_DOWN + (size_t)DM * FF * 2 <= 17 * MiB && W_O + (size_t)DM * DM * 2 <= 17 * MiB, "weight region");
constexpr size_t WS_XN = 18 * MiB;
constexpr size_t WS_RA = 52 * MiB;
constexpr size_t RA_ZA = 0, RA_ZC = (size_t)MROWS * 768 * 2, RA_ZZ = RA_ZC + (size_t)MROWS * 1536 * 2;
constexpr size_t WS_RB = 146 * MiB;
constexpr size_t PREP_UNIT = 73728, PU_KC = 0, PU_QD = 16384, PU_KD = 32768, PU_VU = 49152, PU_QK = 65536;
constexpr size_t WS_RC = 218 * MiB;
constexpr size_t WS_GB = 252 * MiB;
constexpr size_t WS_GT = WS_GB + 640 * 1024;
constexpr size_t WS_WAB = 253 * MiB;
constexpr size_t WS_MB2 = 254 * MiB;
constexpr size_t WS_END = 256 * MiB;
static_assert(WS_XN + (size_t)MROWS * DM * 2 <= WS_RA && WS_RA + (size_t)MROWS * 2816 * 2 <= WS_RB && WS_RB + 1024 * PREP_UNIT <= WS_RC && (size_t)MROWS * DM * 4 <= 72 * MiB &&
              WS_RC + 2 * (size_t)MROWS * 512 * 2 <= WS_GB && (size_t)MROWS * 32 <= 640 * 1024 && (size_t)MP * 512 * 4 <= (size_t)MROWS * 1536 * 2, "d_ws map");
constexpr int CW_BAR = 1024;

constexpr int RING_BYTES = 131072;
constexpr int PREP_HALF = 69888;
constexpr int MISC_OFF = 2 * PREP_HALF;
constexpr int LDS_BYTES = MISC_OFF + 256;
constexpr int NWAVES = 8;

struct Frame {
    LAS unsigned char* lds;
    int tid, lane, wave, vcu, G;
    float* out; unsigned char* ws;
};

__device__ __forceinline__ float bf2f(unsigned short b) { return __builtin_bit_cast(float, (unsigned)b << 16); }
__device__ __forceinline__ float blo(unsigned w) { return __builtin_bit_cast(float, w << 16); }
__device__ __forceinline__ float bhi(unsigned w) { return __builtin_bit_cast(float, w & 0xffff0000u); }
__device__ __forceinline__ float wave_sum(float v) {
#pragma unroll
    for (int o = 1; o < 64; o <<= 1) v += __shfl_xor(v, o);
    return v;
}
__device__ __forceinline__ float siluf(float x) { return x * __builtin_amdgcn_rcpf(1.0f + __expf(-x)); }
__device__ __forceinline__ float sigmf(float x) { return __builtin_amdgcn_rcpf(1.0f + __expf(-x)); }
#define MFMA16(a, b, c) __builtin_amdgcn_mfma_f32_16x16x32_bf16((a), (b), (c), 0, 0, 0)
#define LDS_FENCE() asm volatile("s_waitcnt lgkmcnt(0)" ::: "memory")

__device__ __forceinline__ void transpose_item(const float* W, int K, int N, bf16* WT, int k0, int sc0, int dr0, LAS float* scr, int lane) {
#pragma unroll 8
    for (int i = 0; i < 32; ++i) { const int kk = 2 * i + (lane >> 5); scr[kk * 33 + (lane & 31)] = W[(size_t)(k0 + kk) * N + sc0 + (lane & 31)]; }
    LDS_WAIT(); asm volatile("" ::: "memory");
    const int c = lane & 7;
#pragma unroll
    for (int j = 0; j < 4; ++j) { const int n = (lane >> 3) + 8 * j; const LAS float* s = scr + (8 * c) * 33 + n;
        v4u o; o.x = pk2(s[0 * 33], s[1 * 33]); o.y = pk2(s[2 * 33], s[3 * 33]); o.z = pk2(s[4 * 33], s[5 * 33]); o.w = pk2(s[6 * 33], s[7 * 33]);
        *(GAS v4u*)(WT + (size_t)(dr0 + n) * K + k0 + 8 * c) = o; }
    LDS_WAIT(); asm volatile("" ::: "memory");
}
__device__ __forceinline__ void conv_up(const Frame& F, const float* W, bf16* WT, LAS float* scr, int it) {
    const int kb = it / 176, nb = it % 176, sc0 = nb * 32;
    const int j = sc0 < FF ? sc0 : sc0 - FF; const int dr0 = 256 * (j >> 7) + (sc0 < FF ? 0 : 128) + (j & 127);
    transpose_item(W, DM, NUP, WT, kb * 64, sc0, dr0, scr, F.lane);
}
__device__ __forceinline__ void conv_plain(const Frame& F, const float* W, int K, int N, int ncols, int scoff, bf16* WT, LAS float* scr, int it) {
    const int nblk = ncols / 32, kb = it / nblk, nb = it % nblk;
    transpose_item(W, K, N, WT, kb * 64, scoff + nb * 32, nb * 32, scr, F.lane);
}
__device__ __forceinline__ void convert_ffn_weights(const Frame& F, const float* wup, const float* wdown, int scr_base, int it_lo, int it_hi, int rank, int nrank) {
    LAS float* scr = (LAS float*)(F.lds + scr_base + F.wave * 8448);
    bf16* wb = (bf16*)(F.ws + WS_W);
    const int gw = rank * NWAVES + F.wave, NGW = nrank * NWAVES;
    constexpr int I_UP = 16 * 176;
    for (int it = it_lo + gw; it < it_hi; it += NGW) {
        if (it < I_UP) conv_up(F, wup, wb + W_UP / 2, scr, it);
        else conv_plain(F, wdown, FF, DM, DM, 0, wb + W_DOWN / 2, scr, it - I_UP);
    }
}
__device__ __forceinline__ void convert_mix_weights(const Frame& F, const float* w_in, const float* w_a, const float* w_b, const float* w_o, int scr_base, int it_lo, int it_hi, int rank, int nrank) {
    LAS float* scr = (LAS float*)(F.lds + scr_base + F.wave * 8448);
    bf16* wb = (bf16*)(F.ws + WS_W);
    const int gw = rank * NWAVES + F.wave, NGW = nrank * NWAVES;
    constexpr int I1 = 16 * 88, I2 = 16 * 64, I3 = 8 * 32;
    for (int it = it_lo + gw; it < it_hi; it += NGW) {
        int r = it;
        if (r < I1) { conv_plain(F, w_in, DM, INDIM, NZ1, 0, wb + W_IN1 / 2, scr, r); continue; } r -= I1;
        if (r < I2) { conv_plain(F, w_in, DM, INDIM, NGATE, 2824, wb + W_G / 2, scr, r); continue; } r -= I2;
        if (r < I3) { conv_plain(F, w_a, 512, DM, DM, 0, wb + W_A / 2, scr, r); continue; } r -= I3;
        if (r < I3) { conv_plain(F, w_b, 512, DM, DM, 0, wb + W_B / 2, scr, r); continue; } r -= I3;
        conv_plain(F, w_o, DM, DM, DM, 0, wb + W_O / 2, scr, r);
    }
}

template <int MODE, int NSPLIT> __device__ __forceinline__ void rowwise(const Frame& F, const float* wpost, const float* wpre, const float* xp, const float* xs, const float* a_log, const float* dt_bias) {
    const int gw = F.vcu * NWAVES + F.wave, NGW = F.G * NWAVES, lane = F.lane;
#define RW_COL(j) (8 * lane + 512 * ((j) >> 1) + 4 * ((j) & 1))
    float* Y = F.out + O_Y; const float* MBp = (const float*)(F.ws + WS_RB); bf16* XN = (bf16*)(F.ws + WS_XN);
    f32x4 wq[4], wp[4];
#pragma unroll
    for (int j = 0; j < 4; ++j) { if (MODE != 0) wq[j] = *(const f32x4*)(wpost + RW_COL(j)); if (MODE != 3) wp[j] = *(const f32x4*)(wpre + RW_COL(j)); }
    const LAS float* wab = (const LAS float*)F.lds;
    float alog = 0.f, dtb = 0.f;
    if (MODE == 1) { alog = __expf(a_log[lane & 3]); dtb = dt_bias[lane & 3]; }
    for (int m = gw; m < MROWS; m += NGW) {
        f32x4 x[4];
        if (MODE == 0 || MODE == 1) { const float* xr = (m < MP) ? xp + (size_t)m * DM : xs + (size_t)(m - MP) * DM;
#pragma unroll
            for (int j = 0; j < 4; ++j) x[j] = *(const f32x4*)(xr + RW_COL(j));
        } else {
#pragma unroll
            for (int j = 0; j < 4; ++j) x[j] = *(const f32x4*)(Y + (size_t)m * DM + RW_COL(j));
        }
        if (MODE != 0) {
            f32x4 mb[4]; float s = 0.f;
#pragma unroll
            for (int p = 0; p < 2; ++p) {
                if (m < MP) { const v4u mw = *(const v4u*)((const bf16*)MBp + (size_t)m * DM + 8 * lane + 512 * p);
                    mb[2 * p] = (f32x4){blo(mw.x), bhi(mw.x), blo(mw.y), bhi(mw.y)}; mb[2 * p + 1] = (f32x4){blo(mw.z), bhi(mw.z), blo(mw.w), bhi(mw.w)}; }
                else {
#pragma unroll
                    for (int q = 0; q < 2; ++q) { const int j = 2 * p + q; const float* pp = (const float*)(F.ws + WS_RC) + (size_t)(m - MP) * DM + RW_COL(j); mb[j] = *(const f32x4*)pp;
#pragma unroll
                        for (int sp = 1; sp < NSPLIT; ++sp) mb[j] += *(const f32x4*)(pp + (size_t)sp * MS * DM); } }
            }
#pragma unroll
            for (int j = 0; j < 4; ++j) s += (mb[j].x * mb[j].x + mb[j].y * mb[j].y) + (mb[j].z * mb[j].z + mb[j].w * mb[j].w);
            const float r = rsqrtf(wave_sum(s) * (1.f / DM) + EPS) * (MODE == 2 ? 1.0f : 0.5f);
#pragma unroll
            for (int j = 0; j < 4; ++j) { x[j] = x[j] + mb[j] * r * wq[j]; *(f32x4*)(Y + (size_t)m * DM + RW_COL(j)) = x[j]; }
        }
        if (MODE != 3) {
            float s = 0.f;
#pragma unroll
            for (int j = 0; j < 4; ++j) s += (x[j].x * x[j].x + x[j].y * x[j].y) + (x[j].z * x[j].z + x[j].w * x[j].w);
            const float r = rsqrtf(wave_sum(s) * (1.f / DM) + EPS);
            f32x4 h[4];
#pragma unroll
            for (int j = 0; j < 4; ++j) h[j] = x[j] * r * wp[j];
#pragma unroll
            for (int p = 0; p < 2; ++p) { v4u o; o.x = pk2(h[2 * p].x, h[2 * p].y); o.y = pk2(h[2 * p].z, h[2 * p].w); o.z = pk2(h[2 * p + 1].x, h[2 * p + 1].y); o.w = pk2(h[2 * p + 1].z, h[2 * p + 1].w);
                *(v4u*)(XN + (size_t)m * DM + 8 * lane + 512 * p) = o; }
            if (MODE == 1) {
                float d[8];
#pragma unroll
                for (int c = 0; c < 8; ++c) d[c] = 0.f;
#pragma unroll
                for (int j = 0; j < 4; ++j)
#pragma unroll
                    for (int e = 0; e < 4; ++e) { const int sl = ((e * 4 + j) * 64 + lane) * 8; const f32x4 w0 = *(const LAS f32x4*)(wab + sl), w1 = *(const LAS f32x4*)(wab + sl + 4); const float hv = h[j][e];
                        d[0] += hv * w0.x; d[1] += hv * w0.y; d[2] += hv * w0.z; d[3] += hv * w0.w; d[4] += hv * w1.x; d[5] += hv * w1.y; d[6] += hv * w1.z; d[7] += hv * w1.w; }
#pragma unroll
                for (int c = 0; c < 8; ++c) d[c] = wave_sum(d[c]);
                float mine = d[0];
#pragma unroll
                for (int c = 1; c < 8; ++c) mine = (lane == c) ? d[c] : mine;
                if (lane < 8) { float v;
                    if (lane < 4) { const float a = mine + dtb; const float sp = fmaxf(a, 0.f) + log1pf(__expf(-fabsf(a))); v = -alog * sp; }
                    else v = sigmf(mine);
                    ((float*)(F.ws + WS_GB))[(size_t)m * 8 + lane] = v; }
            }
        }
    }
}
#undef RW_COL

template <bool SAMPLE> __device__ __forceinline__ void attn_unit(const Frame& F, const float* cache_k, const float* cache_v, const float* sinks, int b, int kvh, int qb) {
    constexpr int NK = SAMPLE ? 160 : 192, NT = NK / 16, NKS = NK / 32;
    LAS bf16* Ks = (LAS bf16*)(F.lds); LAS bf16* Vt = (LAS bf16*)(F.lds + 27648); LAS bf16* Pw = (LAS bf16*)(F.lds + 53248 + F.wave * 6400);
    const bf16* ZA = (const bf16*)(F.ws + WS_RA + RA_ZA); bf16* OA = (bf16*)(F.ws + WS_RC);
    const int kstart = SAMPLE ? 0 : qb * 64 - 128;
    for (int p = F.tid; p < NK * 8; p += 512) {
        const int kk = p >> 3, part = p & 7;
        v4u kv = {0u, 0u, 0u, 0u}, vv = {0u, 0u, 0u, 0u};
        if (SAMPLE) {
            if (kk < 128) { const size_t o = (((size_t)b * 128 + kk) * 2 + kvh) * 64 + part * 8;
                const f32x4 k0 = *(const f32x4*)(cache_k + o), k1 = *(const f32x4*)(cache_k + o + 4), v0 = *(const f32x4*)(cache_v + o), v1 = *(const f32x4*)(cache_v + o + 4);
                kv.x = pk2(k0.x, k0.y); kv.y = pk2(k0.z, k0.w); kv.z = pk2(k1.x, k1.y); kv.w = pk2(k1.z, k1.w);
                vv.x = pk2(v0.x, v0.y); vv.y = pk2(v0.z, v0.w); vv.z = pk2(v1.x, v1.y); vv.w = pk2(v1.z, v1.w);
            } else if (kk < 136) { const size_t row = (size_t)MP + b * 8 + (kk - 128);
                kv = *(const v4u*)(ZA + row * 768 + 512 + kvh * 64 + part * 8); vv = *(const v4u*)(ZA + row * 768 + 640 + kvh * 64 + part * 8); }
        } else {
            const int tok = kstart + kk;
            if (tok >= 0) { const size_t row = (size_t)b * SEQ + tok;
                kv = *(const v4u*)(ZA + row * 768 + 512 + kvh * 64 + part * 8); vv = *(const v4u*)(ZA + row * 768 + 640 + kvh * 64 + part * 8); }
        }
        *(LAS v4u*)(Ks + kk * 72 + part * 8) = kv;
        const unsigned vw[4] = {vv.x, vv.y, vv.z, vv.w};
#pragma unroll
        for (int i = 0; i < 4; ++i) { Vt[(part * 8 + 2 * i) * 200 + kk] = (bf16)(vw[i] & 0xffffu); Vt[(part * 8 + 2 * i + 1) * 200 + kk] = (bf16)(vw[i] >> 16); }
    }
    __syncthreads();
    const int fr = F.lane & 15, fq = F.lane >> 4;
    if (F.wave < (SAMPLE ? 2 : 8)) {
#pragma unroll 1
        for (int mt = 0; mt < (SAMPLE ? 1 : 2); ++mt) {
            int qi, head; size_t row;
            if (SAMPLE) { const int r = 16 * F.wave + fr; head = kvh * 4 + (r >> 3); qi = r & 7; row = (size_t)MP + b * 8 + qi; }
            else { head = kvh * 4 + (F.wave >> 1); qi = 32 * (F.wave & 1) + 16 * mt + fr; row = (size_t)b * SEQ + qb * 64 + qi; }
            bf16x8 qf[2];
#pragma unroll
            for (int ks = 0; ks < 2; ++ks) qf[ks] = *(const bf16x8*)(ZA + row * 768 + head * 64 + 32 * ks + 8 * fq);
            f32x4 s[NT];
#pragma unroll
            for (int nt = 0; nt < NT; ++nt) { s[nt] = (f32x4){0.f, 0.f, 0.f, 0.f};
#pragma unroll
                for (int ks = 0; ks < 2; ++ks) { const bf16x8 kf = *(const LAS bf16x8*)(Ks + (16 * nt + fr) * 72 + 32 * ks + 8 * fq); s[nt] = MFMA16(kf, qf[ks], s[nt]); } }
            float mx = -1e30f;
#pragma unroll
            for (int nt = 0; nt < NT; ++nt)
#pragma unroll
                for (int j = 0; j < 4; ++j) { const int kk = 16 * nt + 4 * fq + j; const bool valid = (kk > qi) && (kk <= 128 + qi) && (SAMPLE || kstart + kk >= 0);
                    const float v = valid ? s[nt][j] * 0.125f : -1e30f; s[nt][j] = v; mx = fmaxf(mx, v); }
            mx = fmaxf(mx, __shfl_xor(mx, 16)); mx = fmaxf(mx, __shfl_xor(mx, 32));
            const float sink = sinks[head]; mx = fmaxf(mx, sink);
            float sum = 0.f;
#pragma unroll
            for (int nt = 0; nt < NT; ++nt) {
#pragma unroll
                for (int j = 0; j < 4; ++j) { const float p = __expf(s[nt][j] - mx); s[nt][j] = p; sum += p; }
                v2u w; w.x = pk2(s[nt][0], s[nt][1]); w.y = pk2(s[nt][2], s[nt][3]); *(LAS v2u*)(Pw + fr * 200 + 16 * nt + 4 * fq) = w; }
            sum += __shfl_xor(sum, 16); sum += __shfl_xor(sum, 32);
            const float inv = 1.0f / (sum + __expf(sink - mx));
            LDS_FENCE();
            f32x4 o[4];
#pragma unroll
            for (int nd = 0; nd < 4; ++nd) o[nd] = (f32x4){0.f, 0.f, 0.f, 0.f};
#pragma unroll
            for (int ks = 0; ks < NKS; ++ks) { const bf16x8 pf = *(const LAS bf16x8*)(Pw + fr * 200 + 32 * ks + 8 * fq);
#pragma unroll
                for (int nd = 0; nd < 4; ++nd) { const bf16x8 vf = *(const LAS bf16x8*)(Vt + (16 * nd + fr) * 200 + 32 * ks + 8 * fq); o[nd] = MFMA16(vf, pf, o[nd]); } }
#pragma unroll
            for (int nd = 0; nd < 4; ++nd) { v2u w; w.x = pk2(o[nd][0] * inv, o[nd][1] * inv); w.y = pk2(o[nd][2] * inv, o[nd][3] * inv);
                *(v2u*)(OA + row * 512 + head * 64 + 16 * nd + 4 * fq) = w; }
            LDS_FENCE();
        }
    }
    __syncthreads();
}

__device__ __forceinline__ void prep_pair(const Frame& F, const float* conv_w, int pair) {
    const int hb = F.tid >> 8, t = F.tid & 255, hw = F.wave & 3, lane = F.lane, fr = lane & 15, fq = lane >> 4;
    const int uid = 2 * pair + hb, b = uid >> 7, h = (uid >> 5) & 3, ch = uid & 31;
    LAS unsigned char* L = F.lds + hb * PREP_HALF;
    LAS bf16* Xq = (LAS bf16*)L; LAS bf16* Xk = Xq + 64 * 136; LAS bf16* Xv = Xk + 64 * 136;
    LAS float* Mf = (LAS float*)(L + 52224); LAS float* sc = (LAS float*)(L + 52224 + 16384);
    const bf16* ZC = (const bf16*)(F.ws + WS_RA + RA_ZC); const float* GB = (const float*)(F.ws + WS_GB);
    unsigned char* PU = F.ws + WS_RB + (size_t)uid * PREP_UNIT;
    const size_t row0 = (size_t)b * SEQ + ch * 64;
    if (hw == 0) {
        const float g = GB[(row0 + lane) * 8 + h], bt = GB[(row0 + lane) * 8 + 4 + h];
        float c = g;
#pragma unroll
        for (int o = 1; o < 64; o <<= 1) { const float n = __shfl_up(c, o); if (lane >= o) c += n; }
        sc[lane] = c; sc[64 + lane] = bt; sc[128 + lane] = __expf(c);
    }
    {
        const int co = t & 15, tg = t >> 4, trel = ch * 64 + 4 * tg - 3;
        v4u raw[3][7];
#pragma unroll
        for (int grp = 0; grp < 3; ++grp)
#pragma unroll
            for (int k = 0; k < 7; ++k) { const v4u z = {0u, 0u, 0u, 0u};
                raw[grp][k] = (trel + k >= 0) ? *(const v4u*)(ZC + (row0 + 4 * tg - 3 + k) * CONVD + grp * 512 + h * 128 + 8 * co) : z; }
#pragma unroll
        for (int grp = 0; grp < 3; ++grp) { const float* wp = conv_w + grp * 512 + h * 128 + 8 * co;
            f32x4 wv[4][2];
#pragma unroll
            for (int j = 0; j < 4; ++j) { wv[j][0] = *(const f32x4*)(wp + j * CONVD); wv[j][1] = *(const f32x4*)(wp + j * CONVD + 4); }
            LAS bf16* X = grp == 0 ? Xq : (grp == 1 ? Xk : Xv);
#pragma unroll
            for (int i = 0; i < 4; ++i) { float o[8];
#pragma unroll
                for (int e = 0; e < 8; ++e) o[e] = 0.f;
#pragma unroll
                for (int j = 0; j < 4; ++j) { const v4u r = raw[grp][i + j]; const float xv[8] = {blo(r.x), bhi(r.x), blo(r.y), bhi(r.y), blo(r.z), bhi(r.z), blo(r.w), bhi(r.w)};
#pragma unroll
                    for (int e = 0; e < 8; ++e) o[e] += wv[j][e >> 2][e & 3] * xv[e]; }
                v4u pk; pk.x = pk2(siluf(o[0]), siluf(o[1])); pk.y = pk2(siluf(o[2]), siluf(o[3])); pk.z = pk2(siluf(o[4]), siluf(o[5])); pk.w = pk2(siluf(o[6]), siluf(o[7]));
                *(LAS v4u*)(X + (4 * tg + i) * 136 + 8 * co) = pk; }
        }
    }
    __syncthreads();
    if (t < 128) { const int grp = t >> 6, i = t & 63; const LAS bf16* X = (grp == 0 ? Xq : Xk) + i * 136; float ss = 0.f;
#pragma unroll
        for (int k = 0; k < 16; ++k) { const v4u w = *(const LAS v4u*)(X + 8 * k); const float a0 = blo(w.x), a1 = bhi(w.x), a2 = blo(w.y), a3 = bhi(w.y), a4 = blo(w.z), a5 = bhi(w.z), a6 = blo(w.w), a7 = bhi(w.w);
            ss += (a0 * a0 + a1 * a1) + (a2 * a2 + a3 * a3) + (a4 * a4 + a5 * a5) + (a6 * a6 + a7 * a7); }
        sc[192 + grp * 64 + i] = rsqrtf(ss + EPS); }
    __syncthreads();
    {
        const int i = 16 * hw + fr;
        f32x4 kk[4], qk[4];
#pragma unroll
        for (int nt = 0; nt < 4; ++nt) { kk[nt] = (f32x4){0.f, 0.f, 0.f, 0.f}; qk[nt] = (f32x4){0.f, 0.f, 0.f, 0.f}; }
#pragma unroll
        for (int ks = 0; ks < 4; ++ks) { const bf16x8 ak = *(const LAS bf16x8*)(Xk + i * 136 + 32 * ks + 8 * fq), aq = *(const LAS bf16x8*)(Xq + i * 136 + 32 * ks + 8 * fq);
#pragma unroll
            for (int nt = 0; nt < 4; ++nt) { const bf16x8 bk = *(const LAS bf16x8*)(Xk + (16 * nt + fr) * 136 + 32 * ks + 8 * fq); kk[nt] = MFMA16(bk, ak, kk[nt]); qk[nt] = MFMA16(bk, aq, qk[nt]); } }
        const float gi = sc[i], bi = sc[64 + i], rki = sc[256 + i], rqi = sc[192 + i] * 0.08838834764831845f;
        bf16* QKg = (bf16*)(PU + PU_QK);
#pragma unroll
        for (int nt = 0; nt < 4; ++nt) { f32x4 mv, qv;
#pragma unroll
            for (int jj = 0; jj < 4; ++jj) { const int j = 16 * nt + 4 * fq + jj; const float gj = sc[j], rkj = sc[256 + j];
                const float dec = (i >= j) ? __expf(gi - gj) : 0.f;
                mv[jj] = (i > j) ? kk[nt][jj] * rki * rkj * bi * dec : 0.f; qv[jj] = (i >= j) ? qk[nt][jj] * rqi * rkj * dec : 0.f; }
            *(LAS f32x4*)(Mf + i * 64 + 16 * nt + 4 * fq) = mv;
            v2u w; w.x = pk2(qv[0], qv[1]); w.y = pk2(qv[2], qv[3]); *(v2u*)(QKg + i * 64 + 16 * nt + 4 * fq) = w; }
    }
    __syncthreads();
    {
        float x[64];
        if (t < 128) {
#pragma unroll
            for (int i = 0; i < 64; ++i) x[i] = bf2f(Xk[i * 136 + t]) * (sc[256 + i] * sc[64 + i] * sc[128 + i]);
        } else {
#pragma unroll
            for (int i = 0; i < 64; ++i) x[i] = bf2f(Xv[i * 136 + (t - 128)]) * sc[64 + i];
        }
#pragma unroll
        for (int bb = 0; bb < 4; ++bb) {
#pragma unroll
            for (int j4 = 0; j4 < 16 * bb; j4 += 4) { f32x4 m[16];
#pragma unroll
                for (int r = 0; r < 16; ++r) m[r] = *(const LAS f32x4*)(Mf + (16 * bb + r) * 64 + j4);
                __builtin_amdgcn_sched_barrier(0);
#pragma unroll
                for (int r = 0; r < 16; ++r) { float a = x[16 * bb + r]; a = __builtin_fmaf(-m[r][0], x[j4], a); a = __builtin_fmaf(-m[r][1], x[j4 + 1], a); a = __builtin_fmaf(-m[r][2], x[j4 + 2], a); a = __builtin_fmaf(-m[r][3], x[j4 + 3], a); x[16 * bb + r] = a; }
                __builtin_amdgcn_sched_barrier(0); }
#pragma unroll
            for (int r = 1; r < 16; ++r) { f32x4 m[4];
#pragma unroll
                for (int q = 0; q <= (r - 1) / 4; ++q) m[q] = *(const LAS f32x4*)(Mf + (16 * bb + r) * 64 + 16 * bb + 4 * q);
                float a = x[16 * bb + r];
#pragma unroll
                for (int j = 0; j < r; ++j) a -= m[j >> 2][j & 3] * x[16 * bb + j];
                x[16 * bb + r] = a; }
        }
        if (t < 128) { bf16* KC = (bf16*)(PU + PU_KC);
#pragma unroll
            for (int i = 0; i < 64; ++i) KC[i * 128 + t] = (bf16)f2bf(x[i]);
        } else { bf16* VU = (bf16*)(PU + PU_VU) + (t - 128) * 64;
#pragma unroll
            for (int k = 0; k < 8; ++k) { v4u w; w.x = pk2(x[8 * k], x[8 * k + 1]); w.y = pk2(x[8 * k + 2], x[8 * k + 3]); w.z = pk2(x[8 * k + 4], x[8 * k + 5]); w.w = pk2(x[8 * k + 6], x[8 * k + 7]); *(v4u*)(VU + 8 * k) = w; }
        }
    }
    {
        const int i = t >> 2, d0 = (t & 3) * 32; const float sq = sc[192 + i] * 0.08838834764831845f * sc[128 + i];
        bf16* QD = (bf16*)(PU + PU_QD) + i * 128 + d0;
#pragma unroll
        for (int k = 0; k < 4; ++k) { const v4u w = *(const LAS v4u*)(Xq + i * 136 + d0 + 8 * k); v4u o;
            o.x = pk2(blo(w.x) * sq, bhi(w.x) * sq); o.y = pk2(blo(w.y) * sq, bhi(w.y) * sq); o.z = pk2(blo(w.z) * sq, bhi(w.z) * sq); o.w = pk2(blo(w.w) * sq, bhi(w.w) * sq); *(v4u*)(QD + 8 * k) = o; }
        const int d = t >> 1, c0 = (t & 1) * 32; const float gl = sc[63];
        bf16* KD = (bf16*)(PU + PU_KD) + d * 64 + c0;
#pragma unroll
        for (int k = 0; k < 4; ++k) { float v[8];
#pragma unroll
            for (int e = 0; e < 8; ++e) { const int c = c0 + 8 * k + e; v[e] = bf2f(Xk[c * 136 + d]) * sc[256 + c] * __expf(gl - sc[c]); }
            v4u o; o.x = pk2(v[0], v[1]); o.y = pk2(v[2], v[3]); o.z = pk2(v[4], v[5]); o.w = pk2(v[6], v[7]); *(v4u*)(KD + 8 * k) = o; }
        if (t == 0) ((float*)(F.ws + WS_GT))[uid] = sc[128 + 63];
    }
    __syncthreads();
}

struct ScanOps { bf16x8 kd[2], kc[4], qd[4], qkf[2]; v2u vu; float gt; };
__device__ __forceinline__ void scan_load(ScanOps& o, const unsigned char* PU, const float* GT, int idx, int w, int es, int fr, int fq) {
    o.gt = GT[idx];
#pragma unroll
    for (int ks = 0; ks < 2; ++ks) o.kd[ks] = *(const bf16x8*)((const bf16*)(PU + PU_KD) + (16 * w + fr) * 64 + 32 * ks + 8 * fq);
    if (w < 4) {
#pragma unroll
        for (int ks = 0; ks < 4; ++ks) { o.kc[ks] = *(const bf16x8*)((const bf16*)(PU + PU_KC) + (16 * w + fr) * 128 + 32 * ks + 8 * fq); o.qd[ks] = *(const bf16x8*)((const bf16*)(PU + PU_QD) + (16 * w + fr) * 128 + 32 * ks + 8 * fq); }
#pragma unroll
        for (int ks = 0; ks < 2; ++ks) o.qkf[ks] = *(const bf16x8*)((const bf16*)(PU + PU_QK) + (16 * w + fr) * 64 + 32 * ks + 8 * fq);
        o.vu = *(const v2u*)((const bf16*)(PU + PU_VU) + (16 * es + fr) * 64 + 16 * w + 4 * fq);
    }
}
#define LDS_BAR() asm volatile("s_waitcnt lgkmcnt(0)\n\ts_barrier" ::: "memory")
#define SCAN_STEP(CUR, NXT, n_) do { const int n__ = (n_); const int nn = n__ < 31 ? n__ + 1 : 31; \
        scan_load(NXT, PU0 + (size_t)nn * PREP_UNIT, GT, bh * 32 + nn, w, es, fr, fq); \
        f32x4 O = {0.f, 0.f, 0.f, 0.f}; \
        if (w < 4) { f32x4 X = {0.f, 0.f, 0.f, 0.f}; \
            _Pragma("unroll") for (int ks = 0; ks < 4; ++ks) { const bf16x8 sf = *(const LAS bf16x8*)(Ss + fr * 136 + 32 * ks + 8 * fq); X = MFMA16(CUR.kc[ks], sf, X); O = MFMA16(CUR.qd[ks], sf, O); } \
            v2u o; o.x = pk2(blo(CUR.vu.x) - X[0], bhi(CUR.vu.x) - X[1]); o.y = pk2(blo(CUR.vu.y) - X[2], bhi(CUR.vu.y) - X[3]); \
            *(LAS v2u*)(Vn + fr * 72 + 16 * w + 4 * fq) = o; } \
        LDS_BAR(); \
        bf16x8 vf[2]; \
        _Pragma("unroll") for (int ks = 0; ks < 2; ++ks) vf[ks] = *(const LAS bf16x8*)(Vn + fr * 72 + 32 * ks + 8 * fq); \
        if (w < 4) { \
            _Pragma("unroll") for (int ks = 0; ks < 2; ++ks) O = MFMA16(CUR.qkf[ks], vf[ks], O); \
            const size_t row = (size_t)b * SEQ + 64 * n__ + 16 * w + 4 * fq; \
            _Pragma("unroll") for (int j = 0; j < 4; ++j) OBR[(row + j) * 512 + h * 128 + 16 * es + fr] = O[j]; } \
        S = S * CUR.gt; \
        _Pragma("unroll") for (int ks = 0; ks < 2; ++ks) S = MFMA16(CUR.kd[ks], vf[ks], S); \
        { v2u o; o.x = pk2(S[0], S[1]); o.y = pk2(S[2], S[3]); *(LAS v2u*)(Ss + fr * 136 + 16 * w + 4 * fq) = o; } \
        LDS_BAR(); } while (0)
__device__ __forceinline__ void scan_unit(const Frame& F, int unit) {
    const int bh = unit >> 3, es = unit & 7, b = bh >> 2, h = bh & 3, w = F.wave, lane = F.lane, fr = lane & 15, fq = lane >> 4;
    LAS bf16* Ss = (LAS bf16*)F.lds; LAS bf16* Vn = (LAS bf16*)(F.lds + 4352);
    for (int p = F.tid; p < (4352 + 2304) / 4; p += 512) ((LAS unsigned*)F.lds)[p] = 0u;
    float* OBR = (float*)(F.ws + WS_RA + RA_ZC);
    const unsigned char* PU0 = F.ws + WS_RB + (size_t)(bh * 32) * PREP_UNIT; const float* GT = (const float*)(F.ws + WS_GT);
    f32x4 S = {0.f, 0.f, 0.f, 0.f};
    ScanOps opA, opB;
    scan_load(opA, PU0, GT, bh * 32, w, es, fr, fq);
    __syncthreads();
#pragma unroll 1
    for (int n = 0; n < 32; n += 2) { SCAN_STEP(opA, opB, n); SCAN_STEP(opB, opA, n + 1); }
    float* DP = F.out + O_DP + (size_t)bh * 128 * 128;
#pragma unroll
    for (int j = 0; j < 4; ++j) DP[(16 * w + 4 * fq + j) * 128 + 16 * es + fr] = S[j];
    __syncthreads();
}

__device__ __forceinline__ void dn_sample_unit(const Frame& F, const float* state_conv, const float* state_delta, const float* conv_w, const float* out_norm, int unit) {
    const int b = unit >> 2, h = unit & 3, tid = F.tid, e = tid & 127, dq = tid >> 7, lane = F.lane, w = F.wave;
    LAS float* X = (LAS float*)F.lds;
    LAS float* scl = (LAS float*)(F.lds + 12288);
    LAS float* pA = (LAS float*)(F.lds + 12544);
    LAS float* pB = (LAS float*)(F.lds + 14592);
    LAS float* osm = (LAS float*)(F.lds + 16640);
    const bf16* ZC = (const bf16*)(F.ws + WS_RA + RA_ZC); const bf16* ZZ = (const bf16*)(F.ws + WS_RA + RA_ZZ); const float* GB = (const float*)(F.ws + WS_GB);
    bf16* OB = (bf16*)(F.ws + WS_RC) + (size_t)MROWS * 512;
    const size_t row0 = (size_t)MP + b * 8;
#pragma unroll
    for (int r = 0; r < 6; ++r) { const int idx = tid + 512 * r, grp = idx >> 10, i = (idx >> 7) & 7, c = idx & 127, chn = grp * 512 + h * 128 + c;
        float acc = 0.f;
#pragma unroll
        for (int j = 0; j < 4; ++j) { const int tt = i - 3 + j; const float xv = tt < 0 ? state_conv[((size_t)b * 3 + (3 + tt)) * CONVD + chn] : bf2f(ZC[(row0 + tt) * CONVD + chn]); acc += conv_w[j * CONVD + chn] * xv; }
        X[idx] = siluf(acc); }
    if (tid < 8) { scl[16 + tid] = GB[(row0 + tid) * 8 + h]; scl[24 + tid] = GB[(row0 + tid) * 8 + 4 + h]; }
    __syncthreads();
    { const float q0 = X[w * 128 + lane], q1 = X[w * 128 + lane + 64], k0 = X[1024 + w * 128 + lane], k1 = X[1024 + w * 128 + lane + 64];
      const float sq = wave_sum(q0 * q0 + q1 * q1), sk = wave_sum(k0 * k0 + k1 * k1);
      if (lane == 0) { scl[w] = rsqrtf(sq + EPS) * 0.08838834764831845f; scl[8 + w] = rsqrtf(sk + EPS); } }
    float s[32];
    const float* S0 = state_delta + ((size_t)unit * 128 + 32 * dq) * 128 + e;
#pragma unroll
    for (int r = 0; r < 32; ++r) s[r] = S0[(size_t)r * 128];
    __syncthreads();
#pragma unroll 1
    for (int i = 0; i < 8; ++i) {
        const float eg = __expf(scl[16 + i]), bt = scl[24 + i], rk = scl[8 + i], rq = scl[i];
        const LAS float* kr = X + 1024 + i * 128 + 32 * dq; const LAS float* qr = X + i * 128 + 32 * dq;
        float p = 0.f;
#pragma unroll
        for (int r = 0; r < 32; ++r) { s[r] *= eg; p += kr[r] * s[r]; }
        pA[dq * 128 + e] = p * rk;
        __syncthreads();
        const float kS = (pA[e] + pA[128 + e]) + (pA[256 + e] + pA[384 + e]);
        const float u = bt * (X[2048 + i * 128 + e] - kS) * rk;
        float p2 = 0.f;
#pragma unroll
        for (int r = 0; r < 32; ++r) { s[r] += kr[r] * u; p2 += qr[r] * s[r]; }
        pB[dq * 128 + e] = p2 * rq;
        __syncthreads();
        if (dq == 0) osm[i * 128 + e] = (pB[e] + pB[128 + e]) + (pB[256 + e] + pB[384 + e]);
    }
    __syncthreads();
    {
        const float o0 = osm[w * 128 + lane], o1 = osm[w * 128 + lane + 64];
        const float r = rsqrtf(wave_sum(o0 * o0 + o1 * o1) * (1.f / 128.f) + EPS);
        const size_t row = row0 + w;
        const float z0 = bf2f(ZZ[row * 512 + h * 128 + lane]), z1 = bf2f(ZZ[row * 512 + h * 128 + lane + 64]);
        OB[row * 512 + h * 128 + lane] = (bf16)f2bf(o0 * r * out_norm[lane] * siluf(z0));
        OB[row * 512 + h * 128 + lane + 64] = (bf16)f2bf(o1 * r * out_norm[lane + 64] * siluf(z1));
    }
    float* DSo = F.out + O_DS + ((size_t)unit * 128 + 32 * dq) * 128 + e;
#pragma unroll
    for (int r = 0; r < 32; ++r) DSo[(size_t)r * 128] = s[r];
    __syncthreads();
}


__device__ __forceinline__ void gated_norm_prompt(const Frame& F, const float* out_norm) {
    const int nbusy = (544 - 2 * F.G > 0 && 544 - 2 * F.G < F.G) ? 544 - 2 * F.G : 0;
    if ((int)blockIdx.x < nbusy) return;
    const int gw = ((int)blockIdx.x - nbusy) * NWAVES + F.wave, NGW = (F.G - nbusy) * NWAVES, lane = F.lane, head = lane >> 4, e0 = (lane & 15) * 8;
    const float* OBR = (const float*)(F.ws + WS_RA + RA_ZC); const bf16* ZZ = (const bf16*)(F.ws + WS_RA + RA_ZZ); bf16* OB = (bf16*)(F.ws + WS_RC) + (size_t)MROWS * 512;
    const f32x4 w0 = *(const f32x4*)(out_norm + e0), w1 = *(const f32x4*)(out_norm + e0 + 4);
    for (int m = gw; m < MP; m += NGW) {
        const size_t o = (size_t)m * 512 + head * 128 + e0;
        const f32x4 a = *(const f32x4*)(OBR + o), c = *(const f32x4*)(OBR + o + 4); const v4u z = *(const v4u*)(ZZ + o);
        float ss = (a.x * a.x + a.y * a.y) + (a.z * a.z + a.w * a.w) + (c.x * c.x + c.y * c.y) + (c.z * c.z + c.w * c.w);
        ss += __shfl_xor(ss, 1); ss += __shfl_xor(ss, 2); ss += __shfl_xor(ss, 4); ss += __shfl_xor(ss, 8);
        const float r = rsqrtf(ss * (1.f / 128.f) + EPS);
        v4u ov; ov.x = pk2(a.x * r * w0.x * siluf(blo(z.x)), a.y * r * w0.y * siluf(bhi(z.x))); ov.y = pk2(a.z * r * w0.z * siluf(blo(z.y)), a.w * r * w0.w * siluf(bhi(z.y)));
        ov.z = pk2(c.x * r * w1.x * siluf(blo(z.z)), c.y * r * w1.y * siluf(bhi(z.z))); ov.w = pk2(c.z * r * w1.z * siluf(blo(z.w)), c.w * r * w1.w * siluf(bhi(z.w)));
        *(v4u*)(OB + o) = ov;
    }
}

__device__ __forceinline__ void store8_bf(float* dst, v4u w) {
    *(f32x4*)dst = (f32x4){blo(w.x), bhi(w.x), blo(w.y), bhi(w.y)}; *(f32x4*)(dst + 4) = (f32x4){blo(w.z), bhi(w.z), blo(w.w), bhi(w.w)};
}
template <int PART> __device__ __forceinline__ void copy_outputs(const Frame& F, const float* cache_k, const float* cache_v, int rank, int nrank) {
    const bf16* ZA = (const bf16*)(F.ws + WS_RA + RA_ZA); const bf16* ZC = (const bf16*)(F.ws + WS_RA + RA_ZC);
    int t_ = F.wave * 64 + hw_lane(); asm volatile("" : "+v"(t_));
    const int gt = rank * 512 + t_, GS = nrank * 512;
    if (PART == 0) {
    for (int g = gt; g < 32768; g += GS) { const int which = g >> 14, rem8 = g & 16383, br = rem8 >> 4, c8 = (rem8 & 15) * 8, b = br >> 7, r = br & 127;
        store8_bf(F.out + O_KP + (size_t)which * 131072 + (size_t)br * 128 + c8, *(const v4u*)(ZA + ((size_t)b * SEQ + 1920 + r) * 768 + 512 + which * 128 + c8)); }
    for (int g0 = gt; g0 < 524288; g0 += 4 * GS) {
        f32x4 va[4], vb[4]; v4u vz[4]; float* dsts[4]; bool live[4], fromc[4];
#pragma unroll
        for (int it = 0; it < 4; ++it) { const int g = g0 + it * GS; live[it] = g < 524288;
            const int which = g >> 18, rem8 = g & 262143, br = rem8 >> 4, c8 = (rem8 & 15) * 8, b = br >> 7, r = br & 127;
            dsts[it] = F.out + O_KS + (size_t)which * 2097152 + (size_t)br * 128 + c8; fromc[it] = r < 120;
            if (live[it]) { if (fromc[it]) { const float* src = (which ? cache_v : cache_k) + ((size_t)b * 128 + r + 8) * 128 + c8; va[it] = *(const f32x4*)src; vb[it] = *(const f32x4*)(src + 4); }
                            else vz[it] = *(const v4u*)(ZA + ((size_t)MP + b * 8 + (r - 120)) * 768 + 512 + which * 128 + c8); } }
#pragma unroll
        for (int it = 0; it < 4; ++it) if (live[it]) { if (fromc[it]) { *(f32x4*)dsts[it] = va[it]; *(f32x4*)(dsts[it] + 4) = vb[it]; } else store8_bf(dsts[it], vz[it]); }
    }
    }
    if (PART == 1) {
    for (int g = gt; g < 4608; g += GS) { const int idx = g * 8, b = idx / 4608, j = (idx % 4608) / CONVD, c = idx % CONVD;
        store8_bf(F.out + O_CP + idx, *(const v4u*)(ZC + ((size_t)b * SEQ + 2045 + j) * CONVD + c)); }
    for (int g = gt; g < 73728; g += GS) { const int idx = g * 8, b = idx / 4608, j = (idx % 4608) / CONVD, c = idx % CONVD;
        store8_bf(F.out + O_CS + idx, *(const v4u*)(ZC + ((size_t)MP + b * 8 + 5 + j) * CONVD + c)); }
    }
}


struct Args { const float* in[25]; float* out; unsigned char* ws; };
typedef const __attribute__((address_space(4))) char* kaptr_t;
__device__ __forceinline__ const float* ldarg(int i) { kaptr_t ka = (kaptr_t)__builtin_amdgcn_kernarg_segment_ptr(); asm volatile("" : "+s"(ka)); return *(const float* const __attribute__((address_space(4)))*)(ka + 8 * i); }
#define ARG(i) ldarg(i)
__global__ void __launch_bounds__(NWAVES * 64, 2) mega_fwd(Args args) {
    extern __shared__ __attribute__((aligned(16))) unsigned char lds_raw[];
    Frame F;
    F.lds = (LAS unsigned char*)lds_raw;
    F.tid = threadIdx.x; F.lane = F.tid & 63; F.wave = __builtin_amdgcn_readfirstlane(F.tid >> 6);
    F.G = gridDim.x; { const int bx = blockIdx.x; F.vcu = (F.G % 8 == 0) ? (bx % 8) * (F.G / 8) + bx / 8 : bx; }
    F.out = (float*)ldarg(25); F.ws = (unsigned char*)ldarg(26);
    volatile LAS unsigned* MISC = (volatile LAS unsigned*)(F.lds + MISC_OFF);
    if (F.tid < 64) MISC[F.tid] = 0u;
    __syncthreads();
    XcdBarrier bar = xcd_barrier_post((unsigned*)(F.ws + WS_CTL) + CW_BAR, MISC + 8, F.tid == 0);
#define GRID_BAR() do { xcd_barrier(bar, F.tid == 0); int t_ = F.wave * 64 + hw_lane(); asm volatile("" : "+v"(t_)); F.tid = t_; F.lane = t_ & 63; } while (0)
    bf16* wb = (bf16*)(F.ws + WS_W); bf16* XN = (bf16*)(F.ws + WS_XN);
    bf16* ACT = (bf16*)(F.ws + WS_RA); bf16* ZA = (bf16*)(F.ws + WS_RA + RA_ZA); bf16* ZC = (bf16*)(F.ws + WS_RA + RA_ZC); bf16* ZZ = (bf16*)(F.ws + WS_RA + RA_ZZ);
    float* MB = (float*)(F.ws + WS_RB); bf16* SG = (bf16*)(F.ws + WS_RB);
    bf16* OA = (bf16*)(F.ws + WS_RC); bf16* OB = OA + (size_t)MROWS * 512;
    bf16* MB2v = (bf16*)(F.ws + WS_MB2) - (size_t)MP * DM;
    const int cu = (int)blockIdx.x;

    convert_ffn_weights(F, ARG(8), ARG(9), 0, 0, F.G == 256 ? 2816 : 4224, F.vcu, F.G);
    { const size_t gt = (size_t)F.vcu * 512 + F.tid; for (size_t i = gt; i < 8192; i += (size_t)F.G * 512) ((float*)(F.ws + WS_WAB))[i] = ARG(12)[(i >> 3) * INDIM + 2816 + (i & 7)]; }
    rowwise<0, 1>(F, nullptr, ARG(6), ARG(0), ARG(1), nullptr, nullptr);
    GRID_BAR();
    { pg8::Gemm g{XN, XN, wb + W_UP / 2, wb + W_UP / 2, DM, DM / 64}; pg8::StaticOrder S; S.init(MROWS, NUP, F.G, cu); pg8::EpiSwiglu E{ACT, FF};
      pg8::gemm_phase<pg8::EpiSwiglu, pg8::StaticOrder, true, true>(F.lds, g, S, E, F.wave); }
    if (F.G == 256 && cu >= 216) convert_ffn_weights(F, ARG(8), ARG(9), 0, 2816, 4224, cu - 216, 40);
    GRID_BAR();
    { pg8::Gemm g{ACT, ACT, wb + W_DOWN / 2, wb + W_DOWN / 2, FF, FF / 64}; pg8::SplitOrder S; S.so.init(MP, DM, F.G, cu); S.nsplit = 8; S.big_nt = 6; S.nbig = 6; S.small_nt = 4; pg8::EpiMB E{(bf16*)MB, DM, (float*)(F.ws + WS_RC)};
      pg8::gemm_phase<pg8::EpiMB, pg8::SplitOrder, true, true>(F.lds, g, S, E, F.wave); }
    static_assert(W_A + (size_t)DM * 512 * 2 <= W_DOWN, "early mixer weight copies stay below the FFN1 down weights");
    if (F.G == 256 && cu >= 128) convert_mix_weights(F, ARG(12), ARG(18), ARG(19), ARG(20), 0, 0, 2688, cu - 128, 128);
    GRID_BAR();
    { const float* wab = (const float*)(F.ws + WS_WAB); for (int i = F.tid; i < 8192; i += 512) { const int k = i >> 3, c = i & 7, jj = (k >> 9) * 2 + ((k & 7) >> 2); ((LAS float*)F.lds)[((((k & 3) * 4 + jj) * 64 + ((k & 511) >> 3)) * 8) + c] = wab[i]; } }
    if (F.G != 256) convert_mix_weights(F, ARG(12), ARG(18), ARG(19), ARG(20), 32768, 0, 3456, F.vcu, F.G);
    __syncthreads();
    rowwise<1, 8>(F, ARG(7), ARG(10), ARG(0), ARG(1), ARG(15), ARG(16));
    GRID_BAR();
    { pg8::Gemm g{XN, XN, wb + W_IN1 / 2, wb + W_IN1 / 2, DM, DM / 64}; pg8::StaticOrder S; S.init(MROWS, NZ1, F.G, cu); pg8::EpiBf16Z<0> E{ZA, ZC, ZZ, 768, 1536, 512, 3, 9};
      pg8::gemm_phase<pg8::EpiBf16Z<0>, pg8::StaticOrder, true, true>(F.lds, g, S, E, F.wave); }
    if (F.G == 256 && cu >= 236) convert_mix_weights(F, ARG(12), ARG(18), ARG(19), ARG(20), 0, 2688, 3456, cu - 236, 20);
    GRID_BAR();
    copy_outputs<1>(F, nullptr, nullptr, F.vcu, F.G);
    for (int u = F.vcu; u < 512; u += F.G) attn_unit<false>(F, nullptr, nullptr, ARG(13), u >> 6, (u >> 5) & 1, u & 31);
    for (int u = F.vcu; u < 256; u += F.G) attn_unit<true>(F, ARG(2), ARG(3), ARG(13), u >> 1, u & 1, 0);
    for (int u = F.vcu; u < 512; u += F.G) prep_pair(F, ARG(14), u);
    for (int u = F.vcu; u < 512; u += F.G) dn_sample_unit(F, ARG(4), ARG(5), ARG(14), ARG(17), u);
    GRID_BAR();
    for (int u = F.vcu; u < 256; u += F.G) scan_unit(F, u);
    GRID_BAR();
    { pg8::Gemm g{XN, XN, wb + W_G / 2, wb + W_G / 2, DM, DM / 64}; pg8::StaticOrder S; S.init(MROWS, NGATE, F.G, cu); pg8::EpiBf16Z<1> E{SG, SG, SG, 2048, 2048, 2048, 1000, 1000};
      pg8::gemm_phase<pg8::EpiBf16Z<1>, pg8::StaticOrder, true, true>(F.lds, g, S, E, F.wave); }
    gated_norm_prompt(F, ARG(17));
    GRID_BAR();
    { pg8::Gemm g{OA, OB, wb + W_A / 2, wb + W_B / 2, 512, 8}; pg8::PairOrder2 S; S.so.init(MP, DM, F.G, cu); pg8::EpiMerge E{SG, XN, MB2v};
      pg8::gemm_phase<pg8::EpiMerge, pg8::PairOrder2, true, true>(F.lds, g, S, E, F.wave); }
    { const int nb8 = F.G > 32 ? 32 : 0;
      if ((int)blockIdx.x >= nb8) copy_outputs<0>(F, ARG(2), ARG(3), (int)blockIdx.x - nb8, F.G - nb8); }
    GRID_BAR();
    { pg8::Gemm g{XN, MB2v, wb + W_O / 2, wb + W_O / 2, DM, DM / 64}; pg8::SplitOrder2 S; S.so.init(MP, DM, F.G, cu); pg8::EpiMB E{(bf16*)MB, DM, (float*)(F.ws + WS_RC)};
      pg8::gemm_phase<pg8::EpiMB, pg8::SplitOrder2, true, true>(F.lds, g, S, E, F.wave); }
    static_assert(W_DOWN <= W_O, "up2 copy stays below W_O");
    if (F.G == 256 && cu >= 128) convert_ffn_weights(F, ARG(23), ARG(24), 0, 0, 2816, cu - 128, 128);
    GRID_BAR();
    if (F.G != 256) convert_ffn_weights(F, ARG(23), ARG(24), 0, 0, 4224, F.vcu, F.G);
    rowwise<2, 8>(F, ARG(11), ARG(21), nullptr, nullptr, nullptr, nullptr);
    GRID_BAR();
    { pg8::Gemm g{XN, XN, wb + W_UP / 2, wb + W_UP / 2, DM, DM / 64}; pg8::StaticOrder S; S.init(MROWS, NUP, F.G, cu); pg8::EpiSwiglu E{ACT, FF};
      pg8::gemm_phase<pg8::EpiSwiglu, pg8::StaticOrder, true, true>(F.lds, g, S, E, F.wave); }
    if (F.G == 256 && cu >= 216) convert_ffn_weights(F, ARG(23), ARG(24), 0, 2816, 4224, cu - 216, 40);
    GRID_BAR();
    { pg8::Gemm g{ACT, ACT, wb + W_DOWN / 2, wb + W_DOWN / 2, FF, FF / 64}; pg8::SplitOrder S; S.so.init(MP, DM, F.G, cu); S.nsplit = 8; S.big_nt = 6; S.nbig = 6; S.small_nt = 4; pg8::EpiMB E{(bf16*)MB, DM, (float*)(F.ws + WS_RC)};
      pg8::gemm_phase<pg8::EpiMB, pg8::SplitOrder, true, true>(F.lds, g, S, E, F.wave); }
    GRID_BAR();
    rowwise<3, 8>(F, ARG(22), nullptr, nullptr, nullptr, nullptr, nullptr);
}

extern "C" void kernel_launch(void* const* d_in, const int* in_sizes, int n_in, void* d_out, int out_size, void* d_ws, size_t ws_size, hipStream_t stream) {
    static int grid = 0;
    if (grid == 0) {
        if (n_in != 25 || out_size != (int)O_END || ws_size < WS_END) { fprintf(stderr, "kernel_launch: unexpected problem shape (n_in %d out %d ws %zu)\n", n_in, out_size, ws_size); grid = -1; return; }
        int dev = 0, cus = 0, per_cu = 0;
        if (hipGetDevice(&dev) != hipSuccess || hipDeviceGetAttribute(&cus, hipDeviceAttributeMultiprocessorCount, dev) != hipSuccess) { grid = -1; return; }
        if (hipFuncSetAttribute((const void*)mega_fwd, hipFuncAttributeMaxDynamicSharedMemorySize, LDS_BYTES) != hipSuccess) { fprintf(stderr, "kernel_launch: hipFuncSetAttribute failed\n"); grid = -1; return; }
        if (hipOccupancyMaxActiveBlocksPerMultiprocessor(&per_cu, (const void*)mega_fwd, NWAVES * 64, LDS_BYTES) != hipSuccess || per_cu < 1) { fprintf(stderr, "kernel_launch: occupancy query reports %d\n", per_cu); }
        (void)hipGetLastError();
        grid = cus;
    }
    if (grid < 0) return;
    (void)hipMemsetAsync((char*)d_ws + WS_CTL, 0, CTL_ZERO_BYTES, stream);
    Args a{};
    for (int i = 0; i < 25; ++i) a.in[i] = (const float*)d_in[i];
    a.out = (float*)d_out; a.ws = (unsigned char*)d_ws;
    hipLaunchKernelGGL(mega_fwd, dim3(grid), dim3(NWAVES * 64), LDS_BYTES, stream, a);
}
```
